# Optimizing an MI355X kernel written in HIP

```python
import math
import jax, jax.numpy as jnp
from jax import lax
import numpy as np

D_MODEL = 1024
BATCH = 4
SEQ = 8192
DEPTH = 1

CHUNK = 64
Q_BLOCK = 128
POOL_WINDOWS = (2, 4, 8, 16)
POOL_GROUPS = len(POOL_WINDOWS)
POOL_WIDTH = D_MODEL // 2
POOL_GROUP_DIM = POOL_WIDTH // POOL_GROUPS
POOL_OUT_GROUP_DIM = D_MODEL // POOL_GROUPS
N_HEADS = 8
QK_NOPE_DIM = D_MODEL // 16
QK_ROPE_DIM = D_MODEL // 32
V_HEAD_DIM = D_MODEL // 16
Q_LORA_RANK = 3 * D_MODEL // 8
KV_LORA_RANK = D_MODEL // 4
ROPE_THETA = 10000.0
N_BRANCHES = 2
IN_SPLITS = (POOL_WIDTH,
             POOL_WIDTH + Q_LORA_RANK,
             POOL_WIDTH + Q_LORA_RANK + KV_LORA_RANK,
             POOL_WIDTH + Q_LORA_RANK + KV_LORA_RANK + QK_ROPE_DIM)
IN_COLS = IN_SPLITS[-1] + N_BRANCHES * D_MODEL
N_GROUPS = 4
EXPERTS_PER_GROUP = 8
N_EXPERTS = N_GROUPS * EXPERTS_PER_GROUP
TOP_K = 2
D_EXPERT = D_MODEL // 2
MOE_BLOCK = 128
NORM_EPS = 1e-5
DEEPNORM_ALPHA = (2.0 * DEPTH) ** 0.25
DEEPNORM_BETA = (8.0 * DEPTH) ** -0.25

kernel_name = "chunk_causal_pool_mla_hiermoe_deepnorm"


def layer_norm(x, g, b):
    xf = x.astype(jnp.float32)
    mu = jnp.mean(xf, axis=-1, keepdims=True)
    var = jnp.mean(jnp.square(xf - mu), axis=-1, keepdims=True)
    return ((xf - mu) * lax.rsqrt(var + NORM_EPS) * g.astype(jnp.float32) + b.astype(jnp.float32)).astype(x.dtype)


def rms_norm(x, g):
    xf = x.astype(jnp.float32)
    ms = jnp.mean(jnp.square(xf), axis=-1, keepdims=True)
    return (xf * lax.rsqrt(ms + NORM_EPS) * g.astype(jnp.float32)).astype(x.dtype)


def rope_tables(seq):
    inv = 1.0 / (ROPE_THETA ** (jnp.arange(0, QK_ROPE_DIM, 2, dtype=jnp.float32) / QK_ROPE_DIM))
    ang = jnp.arange(seq, dtype=jnp.float32)[:, None] * inv[None, :]
    return jnp.cos(ang), jnp.sin(ang)


def apply_rope(x, cos, sin):
    xf = x.astype(jnp.float32)
    x1, x2 = jnp.split(xf, 2, axis=-1)
    return jnp.concatenate([x1 * cos - x2 * sin, x1 * sin + x2 * cos], axis=-1).astype(x.dtype)


def multiscale_pool(u):
    B, S, _ = u.shape
    uf = u.astype(jnp.float32).reshape(B, S, POOL_GROUPS, POOL_GROUP_DIM)
    cs = jnp.pad(jnp.cumsum(uf, axis=1), ((0, 0), (1, 0), (0, 0), (0, 0)))
    t = jnp.arange(S)
    win = jnp.array(POOL_WINDOWS, dtype=jnp.int32)
    lo = jnp.maximum(t[:, None] + 1 - win[None, :], 0)
    gidx = jnp.arange(POOL_GROUPS)[None, :]
    win_sum = cs[:, 1:] - cs[:, lo, gidx, :]
    count = jnp.minimum(t[:, None] + 1, win[None, :]).astype(jnp.float32)
    return win_sum / count[None, :, :, None] - uf


def mla_branch(c_q, c_kv, k_pe_raw, q_norm_g, w_uq, kv_norm_g, w_ukv, w_mla_o, cos, sin):
    B, S, _ = c_q.shape
    q = (rms_norm(c_q, q_norm_g) @ w_uq).reshape(B, S, N_HEADS, QK_NOPE_DIM + QK_ROPE_DIM)
    q_nope, q_pe = q[..., :QK_NOPE_DIM], q[..., QK_NOPE_DIM:]
    q_pe = apply_rope(q_pe, cos[None, :, None, :], sin[None, :, None, :])
    kv = (rms_norm(c_kv, kv_norm_g) @ w_ukv).reshape(B, S, N_HEADS, QK_NOPE_DIM + V_HEAD_DIM)
    k_nope, v = kv[..., :QK_NOPE_DIM], kv[..., QK_NOPE_DIM:]
    k_pe = apply_rope(k_pe_raw, cos[None], sin[None])
    scale = (QK_NOPE_DIM + QK_ROPE_DIM) ** -0.5
    key_chunk = jnp.arange(S) // CHUNK

    def query_block(i):
        qs = i * Q_BLOCK
        qn = lax.dynamic_slice_in_dim(q_nope, qs, Q_BLOCK, axis=1)
        qp = lax.dynamic_slice_in_dim(q_pe, qs, Q_BLOCK, axis=1)
        s = (jnp.einsum('bqhd,bkhd->bhqk', qn, k_nope)
             + jnp.einsum('bqhd,bkd->bhqk', qp, k_pe)).astype(jnp.float32) * scale
        q_chunk = (qs + jnp.arange(Q_BLOCK)) // CHUNK
        mask = key_chunk[None, :] <= q_chunk[:, None]
        p = jax.nn.softmax(jnp.where(mask[None, None], s, -jnp.inf), axis=-1).astype(v.dtype)
        return jnp.einsum('bhqk,bkhd->bqhd', p, v)

    o = lax.map(query_block, jnp.arange(S // Q_BLOCK))
    o = jnp.transpose(o, (1, 0, 2, 3, 4)).reshape(B, S, N_HEADS * V_HEAD_DIM)
    return o @ w_mla_o


def hier_moe(h, w_rg, b_rg, w_re, b_re, w_gate, w_up, w_down):
    B, S, D = h.shape
    N = B * S
    t = h.reshape(N, D)
    g_prob = jax.nn.softmax((t @ w_rg).astype(jnp.float32) + b_rg.astype(jnp.float32), axis=-1)
    g_idx = jnp.argmax(g_prob, axis=-1)
    g_w = jnp.max(g_prob, axis=-1)
    e_logits = ((t @ w_re).astype(jnp.float32) + b_re.astype(jnp.float32)).reshape(N, N_GROUPS, EXPERTS_PER_GROUP)
    e_logits = jnp.take_along_axis(e_logits, g_idx[:, None, None], axis=1)[:, 0]
    top_p, top_i = lax.top_k(jax.nn.softmax(e_logits, axis=-1), TOP_K)
    gate = g_w[:, None] * top_p / jnp.sum(top_p, axis=-1, keepdims=True)
    expert = g_idx[:, None] * EXPERTS_PER_GROUP + top_i

    A = N * TOP_K
    n_blocks = -(-(A + N_EXPERTS * (MOE_BLOCK - 1)) // MOE_BLOCK)
    R = n_blocks * MOE_BLOCK
    flat_e = expert.reshape(A)
    flat_tok = jnp.repeat(jnp.arange(N), TOP_K)
    flat_w = gate.reshape(A)
    order = jnp.argsort(flat_e)
    sorted_e = flat_e[order]
    counts = jnp.bincount(flat_e, length=N_EXPERTS)
    padded = ((counts + MOE_BLOCK - 1) // MOE_BLOCK) * MOE_BLOCK
    pad_end = jnp.cumsum(padded)
    pad_start = pad_end - padded
    start = jnp.cumsum(counts) - counts
    dest = pad_start[sorted_e] + (jnp.arange(A) - start[sorted_e])
    row_tok = jnp.zeros((R,), jnp.int32).at[dest].set(flat_tok[order].astype(jnp.int32))
    row_w = jnp.zeros((R,), jnp.float32).at[dest].set(flat_w[order])
    block_e = jnp.minimum(jnp.searchsorted(pad_end, jnp.arange(n_blocks) * MOE_BLOCK, side='right'), N_EXPERTS - 1)

    def expert_block(args):
        tok, e = args
        xb = t[tok]
        hid = jax.nn.silu(xb @ w_gate[e]) * (xb @ w_up[e])
        return hid @ w_down[e]

    y = lax.map(expert_block, (row_tok.reshape(n_blocks, MOE_BLOCK), block_e)).reshape(R, D)
    out = jnp.zeros((N, D), jnp.float32).at[row_tok].add(y.astype(jnp.float32) * row_w[:, None])
    return out.astype(h.dtype).reshape(B, S, D)


def setup_inputs(seed: int = 0) -> dict:
    key = jax.random.key(seed)
    ks = jax.random.split(key, 24)
    L = DEPTH
    nrm = lambda k, shape, fan_in, s=1.0: jax.random.normal(k, shape, jnp.float32) * (s * fan_in ** -0.5)
    gain = lambda k, shape: 1.0 + 0.05 * jax.random.normal(k, shape, jnp.float32)
    small = lambda k, shape, s: s * jax.random.normal(k, shape, jnp.float32)
    return {
        "x": jax.random.normal(ks[0], (BATCH, SEQ, D_MODEL), jnp.float32),
        "w_in": nrm(ks[1], (L, D_MODEL, IN_COLS), D_MODEL),
        "pool_mix_w": nrm(ks[2], (L, POOL_GROUPS, POOL_GROUP_DIM, POOL_OUT_GROUP_DIM), POOL_GROUP_DIM),
        "pool_scale": gain(ks[3], (L, D_MODEL)),
        "q_norm_g": gain(ks[4], (L, Q_LORA_RANK)),
        "w_uq": nrm(ks[5], (L, Q_LORA_RANK, N_HEADS * (QK_NOPE_DIM + QK_ROPE_DIM)), Q_LORA_RANK),
        "kv_norm_g": gain(ks[6], (L, KV_LORA_RANK)),
        "w_ukv": nrm(ks[7], (L, KV_LORA_RANK, N_HEADS * (QK_NOPE_DIM + V_HEAD_DIM)), KV_LORA_RANK),
        "w_mla_o": nrm(ks[8], (L, N_HEADS * V_HEAD_DIM, D_MODEL), N_HEADS * V_HEAD_DIM),
        "w_out": nrm(ks[9], (L, D_MODEL, D_MODEL), D_MODEL, DEEPNORM_BETA),
        "ln1_g": gain(ks[10], (L, D_MODEL)),
        "ln1_b": small(ks[11], (L, D_MODEL), 0.02),
        "w_router_group": nrm(ks[12], (L, D_MODEL, N_GROUPS), D_MODEL),
        "b_router_group": small(ks[13], (L, N_GROUPS), 0.01),
        "w_router_expert": nrm(ks[14], (L, D_MODEL, N_EXPERTS), D_MODEL),
        "b_router_expert": small(ks[15], (L, N_EXPERTS), 0.01),
        "w_gate": nrm(ks[16], (L, N_EXPERTS, D_MODEL, D_EXPERT), D_MODEL),
        "w_up": nrm(ks[17], (L, N_EXPERTS, D_MODEL, D_EXPERT), D_MODEL),
        "w_down": nrm(ks[18], (L, N_EXPERTS, D_EXPERT, D_MODEL), D_EXPERT, DEEPNORM_BETA),
        "ln2_g": gain(ks[19], (L, D_MODEL)),
        "ln2_b": small(ks[20], (L, D_MODEL), 0.02),
    }


def reference(x, w_in, pool_mix_w, pool_scale, q_norm_g, w_uq, kv_norm_g, w_ukv, w_mla_o, w_out,
              ln1_g, ln1_b, w_router_group, b_router_group, w_router_expert, b_router_expert,
              w_gate, w_up, w_down, ln2_g, ln2_b):
    B, S, D = x.shape
    cos, sin = rope_tables(S)
    for l in range(DEPTH):
        proj = x @ w_in[l]
        u_pool, c_q, c_kv, k_pe_raw, gate_logits = jnp.split(proj, IN_SPLITS, axis=-1)
        pooled = multiscale_pool(u_pool).astype(x.dtype)
        y_pool = jnp.einsum('bsgc,gcd->bsgd', pooled, pool_mix_w[l]).reshape(B, S, D) * pool_scale[l]
        y_mla = mla_branch(c_q, c_kv, k_pe_raw, q_norm_g[l], w_uq[l], kv_norm_g[l], w_ukv[l],
                           w_mla_o[l], cos, sin)
        g = jax.nn.sigmoid(gate_logits.astype(jnp.float32)).reshape(B, S, N_BRANCHES, D)
        merged = (g[:, :, 0] * y_pool.astype(jnp.float32) + g[:, :, 1] * y_mla.astype(jnp.float32)).astype(x.dtype)
        x = layer_norm(DEEPNORM_ALPHA * x + merged @ w_out[l], ln1_g[l], ln1_b[l])
        moe = hier_moe(x, w_router_group[l], b_router_group[l], w_router_expert[l], b_router_expert[l],
                       w_gate[l], w_up[l], w_down[l])
        x = layer_norm(DEEPNORM_ALPHA * x + moe, ln2_g[l], ln2_b[l])
    return x
```

```cpp
#include <hip/hip_runtime.h>
#include <cstdio>
#include <cstdint>

#ifndef MK_N_LAUNCHES
#define MK_N_LAUNCHES 1
#endif

#define GAS __attribute__((address_space(1)))
#define LAS __attribute__((address_space(3)))
typedef unsigned short bf16;
typedef unsigned v4u __attribute__((ext_vector_type(4)));
typedef unsigned v2u __attribute__((ext_vector_type(2)));
typedef float f32x4 __attribute__((ext_vector_type(4)));
typedef float f32x2 __attribute__((ext_vector_type(2)));
typedef float f32x16 __attribute__((ext_vector_type(16)));
typedef short bf16x8 __attribute__((ext_vector_type(8)));
typedef short s16x4 __attribute__((ext_vector_type(4)));

constexpr int BATCH = 4, SEQ = 8192, D = 1024, M = BATCH * SEQ;
constexpr int NH = 8, QKD = 96, VD = 64;
constexpr int PBW = 3328;
constexpr int C_U = 0, C_CQ = 512, C_CKV = 896, C_KPE = 1152, C_G0 = 1280, C_G1 = 2304;
constexpr int QP = NH * QKD;
constexpr int NEXP = 32, DEXP = 512;
constexpr int RMAX = 73728;
constexpr float EPS = 1e-5f;
constexpr float ALPHA = 1.189207115002721f;
constexpr float LOG2E = 1.4426950408889634f;
constexpr float QSCALE = 0.10206207261596575f * 1.4426950408889634f;

constexpr size_t MiB = 1u << 20, KiB = 1024;
constexpr size_t WS_CTL = 0, CTL_ZERO_BYTES = 1 * MiB;
constexpr size_t WS_SMALL = 1 * MiB;
constexpr size_t SM_RQ = WS_SMALL, SM_RKV = WS_SMALL + 128 * KiB, SM_RECS = WS_SMALL + 256 * KiB, SM_ROWTOK = WS_SMALL + 768 * KiB, SM_ROWW = WS_SMALL + 1088 * KiB,
                 SM_ROWOF = WS_SMALL + 1408 * KiB, SM_BLKCNT = WS_SMALL + 1664 * KiB, SM_PINFO = WS_SMALL + 1696 * KiB, SM_ROPE = WS_SMALL + 1792 * KiB, SM_STATS = WS_SMALL + 3072 * KiB;
constexpr size_t WS_W = 8 * MiB;
constexpr size_t W_IN_T = WS_W, W_POOL_T = WS_W + 7 * MiB, W_UQ_T = WS_W + 7 * MiB + 256 * KiB, W_UKV_T = WS_W + 8 * MiB, W_ROUTER_T = WS_W + 8 * MiB + 512 * KiB,
                 W_MLAO_T = WS_W + 9 * MiB, W_OUT_T = WS_W + 10 * MiB, W_GU_T = WS_W + 12 * MiB, W_DN_T = WS_W + 76 * MiB;
constexpr size_t WS_XB = 120 * MiB;
constexpr size_t WS_POOLED = WS_XB, WS_O = WS_XB + 32 * MiB;
constexpr size_t WS_PB = 184 * MiB;
constexpr size_t WS_Y = WS_PB, WS_VH = WS_PB + 144 * MiB;
constexpr size_t WS_K = 392 * MiB, WS_V = 440 * MiB;
constexpr size_t WS_HID = WS_K;
constexpr size_t WS_END = 472 * MiB;
constexpr size_t OUT_TP = 0, OUT_Q = 64 * MiB;

constexpr int CW_TMO = 0, CW_BAR = 4096;

constexpr int RING_OFF = 0, RING_BYTES = 131072;
constexpr int LDSCTL_OFF = RING_BYTES, MISC_OFF = LDSCTL_OFF + 320, PEXP_OFF = LDSCTL_OFF + 512;
constexpr int LDS_BYTES = 147456;

#define RLX_AGENT __ATOMIC_RELAXED, __HIP_MEMORY_SCOPE_AGENT
#define LDS_WAIT() asm volatile("s_waitcnt lgkmcnt(0)" ::: "memory")
#define VM_WAIT() asm volatile("s_waitcnt vmcnt(0)" ::: "memory")
__device__ __forceinline__ unsigned f2bf(float f) { unsigned u = __builtin_bit_cast(unsigned, f); return (u + 0x7fffu + ((u >> 16) & 1u)) >> 16; }
__device__ __forceinline__ unsigned pk2(float lo, float hi) { return f2bf(lo) | (f2bf(hi) << 16); }
__device__ __forceinline__ float bflo(unsigned w) { return __uint_as_float(w << 16); }
__device__ __forceinline__ float bfhi(unsigned w) { return __uint_as_float(w & 0xffff0000u); }
__device__ __forceinline__ float fast_sigmoid(float x) { return __builtin_amdgcn_rcpf(1.0f + __builtin_amdgcn_exp2f(-x * LOG2E)); }
__device__ __forceinline__ int opaque_tid() { int t = (int)threadIdx.x; asm volatile("" : "+v"(t)); return t; }
__device__ __forceinline__ float wave_sum(float v) {
#pragma unroll
    for (int o = 1; o < 64; o <<= 1) v += __shfl_xor(v, o);
    return v;
}

namespace pg8 {
#define PG8_LAS __attribute__((address_space(3)))
typedef unsigned short bf16_t;
typedef unsigned u32x4 __attribute__((ext_vector_type(4)));
constexpr int BM = 256, BK = 64, HALF = 128, HTB = HALF * BK * 2, STAGE_BYTES = 8 * HTB, NXCD = 8, WGM = 8;

__host__ __device__ __forceinline__ int lds_byte(int r, int c) { const int st = (r >> 4) * 2 + (c >> 5), rr = r & 15, cc = c & 31, ob = rr * 64 + cc * 2; return st * 1024 + (ob ^ (((ob >> 9) & 1) << 5)); }
__host__ __device__ __forceinline__ void stage_rc(int b, int& R, int& C) { const int st = b / 1024, sb = b % 1024, swz = sb ^ (((sb >> 9) & 1) << 5); R = (st >> 1) * 16 + swz / 64; C = (st & 1) * 32 + (swz % 64) / 2; }
__host__ __device__ __forceinline__ int perm32(int rho) { const int n = rho >> 4, i = rho & 15; return 8 * (i >> 2) + 4 * n + (i & 3); }

struct Unit { int pm, pn; };

struct StaticOrder {
    int nM, nN, nwg, G, c;
    __host__ __device__ void init(int nM_, int nN_, int G_, int c_) { nM = nM_; nN = nN_; nwg = nM * nN; G = G_; c = c_; }
    __host__ __device__ bool next(int i, Unit& u) const {
        const long L = (long)i * G + c; if (L >= nwg) return false;
        int wgid = (int)L; { const int q = nwg / NXCD, r = nwg % NXCD, xcd = wgid % NXCD, off = wgid / NXCD; wgid = (xcd < r ? xcd * (q + 1) : r * (q + 1) + (xcd - r) * q) + off; }
        const int nig = WGM * nN, gid = wgid / nig, fm = gid * WGM, gsz = (nM - fm) < WGM ? (nM - fm) : WGM;
        u.pm = fm + ((wgid % nig) % gsz); u.pn = (wgid % nig) / gsz; return true;
    }
};

__device__ __forceinline__ unsigned cvt_pk_bf16(float lo, float hi) { unsigned r; asm volatile("v_cvt_pk_bf16_f32 %0, %1, %2" : "=v"(r) : "v"(lo), "v"(hi)); return r; }

struct OpsPlain {
    static constexpr bool GATHER = false;
    const char* A; const char* Bt; int K, lda; size_t a_pn;
    __device__ __forceinline__ const char* a_base(const Unit& u) const { return A + (size_t)u.pm * ((size_t)BM * lda * 2) + (size_t)u.pn * a_pn; }
    __device__ __forceinline__ const char* b_base(const Unit& u) const { return Bt + (size_t)u.pn * ((size_t)BM * K * 2); }
    __device__ __forceinline__ void a_off(const Unit&, const int (&R)[2], const int (&C)[2], unsigned (&o0)[2], unsigned (&o1)[2]) const {
#pragma unroll
        for (int i = 0; i < 2; ++i) { o0[i] = (unsigned)(R[i] * lda + C[i]) * 2u; o1[i] = o0[i]; } }
};
struct OpsMoe1 {
    static constexpr bool GATHER = true;
    const char* A; const char* Bt; int K, lda; const int* row_tok; const PG8_LAS int* pexp;
    __device__ __forceinline__ const char* a_base(const Unit&) const { return A; }
    __device__ __forceinline__ const char* b_base(const Unit& u) const { const int e = pexp[16 + u.pm]; return Bt + ((size_t)e * 1024 + (size_t)u.pn * BM) * ((size_t)K * 2); }
    __device__ __forceinline__ void a_off(const Unit& u, const int (&R)[2], const int (&C)[2], unsigned (&o0)[2], unsigned (&o1)[2]) const {
#pragma unroll
        for (int i = 0; i < 2; ++i) { const int t0 = row_tok[u.pm * BM + R[i]], t1 = row_tok[u.pm * BM + HALF + R[i]];
            o0[i] = (unsigned)(t0 * lda + C[i]) * 2u; o1[i] = (unsigned)(t1 * lda + C[i]) * 2u; } }
};
struct OpsMoe2 {
    static constexpr bool GATHER = false;
    const char* A; const char* Bt; int K, lda; const PG8_LAS int* pexp;
    __device__ __forceinline__ const char* a_base(const Unit& u) const { return A + (size_t)u.pm * ((size_t)BM * lda * 2); }
    __device__ __forceinline__ const char* b_base(const Unit& u) const { const int e = pexp[16 + u.pm]; return Bt + ((size_t)e * 1024 + (size_t)u.pn * BM) * ((size_t)K * 2); }
    __device__ __forceinline__ void a_off(const Unit&, const int (&R)[2], const int (&C)[2], unsigned (&o0)[2], unsigned (&o1)[2]) const {
#pragma unroll
        for (int i = 0; i < 2; ++i) { o0[i] = (unsigned)(R[i] * lda + C[i]) * 2u; o1[i] = o0[i]; } }
};

#define EPI_LOOP_AI_M for (int ai = 0; ai < 2; ++ai) _Pragma("unroll") for (int m = 0; m < 4; ++m)
__device__ __forceinline__ u32x4 pack8(const f32x4& v0, const f32x4& v1) { u32x4 w; w.x = cvt_pk_bf16(v0[0], v0[1]); w.y = cvt_pk_bf16(v0[2], v0[3]); w.z = cvt_pk_bf16(v1[0], v1[1]); w.w = cvt_pk_bf16(v1[2], v1[3]); return w; }
__device__ __forceinline__ void unpack8(const u32x4& w, f32x4& v0, f32x4& v1) { v0 = (f32x4){bflo(w.x), bfhi(w.x), bflo(w.y), bfhi(w.y)}; v1 = (f32x4){bflo(w.z), bfhi(w.z), bflo(w.w), bfhi(w.w)}; }

struct EpiProj {
    bf16_t* PB;
    __device__ __forceinline__ void operator()(const f32x4 (&acc)[2][2][4][2], const Unit& u, int wr, int wc, int fr, int fq) const {
        const int row0 = u.pm * BM + wr * 64 + fr, col0 = u.pn * BM + wc * 32 + 8 * fq; const bool sig = u.pn >= 5;
#pragma unroll
        EPI_LOOP_AI_M { bf16_t* rowp = PB + (size_t)(row0 + ai * HALF + m * 16) * PBW + col0;
#pragma unroll
            for (int bj = 0; bj < 2; ++bj) { f32x4 v0 = acc[ai][bj][m][0], v1 = acc[ai][bj][m][1];
                if (sig) {
#pragma unroll
                    for (int j = 0; j < 4; ++j) { v0[j] = fast_sigmoid(v0[j]); v1[j] = fast_sigmoid(v1[j]); } }
                *(u32x4*)(rowp + bj * HALF) = pack8(v0, v1); } }
    }
};
struct EpiPool {
    bf16_t* TP; const bf16_t* PB; const float* pscale;
    __device__ __forceinline__ void operator()(const f32x4 (&acc)[2][2][4][2], const Unit& u, int wr, int wc, int fr, int fq) const {
        const int row0 = u.pm * BM + wr * 64 + fr, col0 = u.pn * BM + wc * 32 + 8 * fq;
        f32x4 ps[2][2];
#pragma unroll
        for (int bj = 0; bj < 2; ++bj)
#pragma unroll
            for (int n = 0; n < 2; ++n) ps[bj][n] = *(const f32x4*)(pscale + col0 + bj * HALF + 4 * n);
#pragma unroll
        EPI_LOOP_AI_M { const size_t row = (size_t)(row0 + ai * HALF + m * 16);
#pragma unroll
            for (int bj = 0; bj < 2; ++bj) { const u32x4 gw = *(const u32x4*)(PB + row * PBW + C_G0 + col0 + bj * HALF); f32x4 g0, g1; unpack8(gw, g0, g1);
                const f32x4 v0 = acc[ai][bj][m][0] * ps[bj][0] * g0, v1 = acc[ai][bj][m][1] * ps[bj][1] * g1;
                *(u32x4*)(TP + row * D + col0 + bj * HALF) = pack8(v0, v1); } }
    }
};
struct EpiQ {
    bf16_t* Q; const float* rq; const float* rope;
    __device__ __forceinline__ void operator()(const f32x4 (&acc)[2][2][4][2], const Unit& u, int wr, int wc, int fr, int fq) const {
        const int row0 = u.pm * BM + wr * 64 + fr;
#pragma unroll
        EPI_LOOP_AI_M { const int row = row0 + ai * HALF + m * 16; const float sc = rq[row] * QSCALE; const int pos = row & (SEQ - 1);
#pragma unroll
            for (int bj = 0; bj < 2; ++bj) { f32x4 v0 = acc[ai][bj][m][0] * sc, v1 = acc[ai][bj][m][1] * sc; const int cc = bj * HALF + wc * 32 + 8 * fq;
                if (u.pn < 2) { const int col = u.pn * BM + cc, h = col >> 6, d = col & 63;
                    *(u32x4*)(Q + (size_t)row * QP + h * QKD + d) = pack8(v0, v1); }
                else { const int h = cc >> 5, i2 = cc & 31; const float* rt = rope + ((size_t)pos * 16 + (i2 >> 1)) * 2;
                    const f32x4 c0 = *(const f32x4*)rt, c1 = *(const f32x4*)(rt + 4);
                    const f32x4 o0 = (f32x4){v0[0] * c0[0] - v0[1] * c0[1], v0[0] * c0[1] + v0[1] * c0[0], v0[2] * c0[2] - v0[3] * c0[3], v0[2] * c0[3] + v0[3] * c0[2]};
                    const f32x4 o1 = (f32x4){v1[0] * c1[0] - v1[1] * c1[1], v1[0] * c1[1] + v1[1] * c1[0], v1[2] * c1[2] - v1[3] * c1[3], v1[2] * c1[3] + v1[3] * c1[2]};
                    *(u32x4*)(Q + (size_t)row * QP + h * QKD + 64 + i2) = pack8(o0, o1); } } }
    }
};
struct EpiKV {
    bf16_t* Kf; bf16_t* V; const float* rkv;
    __device__ __forceinline__ void operator()(const f32x4 (&acc)[2][2][4][2], const Unit& u, int wr, int wc, int fr, int fq) const {
        const int row0 = u.pm * BM + wr * 64 + fr;
#pragma unroll
        EPI_LOOP_AI_M { const int row = row0 + ai * HALF + m * 16; const float sc = rkv[row];
#pragma unroll
            for (int bj = 0; bj < 2; ++bj) { const f32x4 v0 = acc[ai][bj][m][0] * sc, v1 = acc[ai][bj][m][1] * sc; const int col = (u.pn & 1) * BM + bj * HALF + wc * 32 + 8 * fq;
                if (u.pn < 2) { const int h = col >> 6, d = col & 63; *(u32x4*)(Kf + (size_t)row * QP + h * QKD + d) = pack8(v0, v1); }
                else *(u32x4*)(V + (size_t)row * 512 + col) = pack8(v0, v1); } }
    }
};
struct EpiMla {
    bf16_t* TP; const bf16_t* PB;
    __device__ __forceinline__ void operator()(const f32x4 (&acc)[2][2][4][2], const Unit& u, int wr, int wc, int fr, int fq) const {
        const int row0 = u.pm * BM + wr * 64 + fr, col0 = u.pn * BM + wc * 32 + 8 * fq;
#pragma unroll
        EPI_LOOP_AI_M { const size_t row = (size_t)(row0 + ai * HALF + m * 16);
#pragma unroll
            for (int bj = 0; bj < 2; ++bj) { const u32x4 gw = *(const u32x4*)(PB + row * PBW + C_G1 + col0 + bj * HALF); const u32x4 tw = *(const u32x4*)(TP + row * D + col0 + bj * HALF);
                f32x4 g0, g1, t0, t1; unpack8(gw, g0, g1); unpack8(tw, t0, t1);
                const f32x4 v0 = t0 + acc[ai][bj][m][0] * g0, v1 = t1 + acc[ai][bj][m][1] * g1;
                *(u32x4*)(TP + row * D + col0 + bj * HALF) = pack8(v0, v1); } }
    }
};
struct EpiOut {
    bf16_t* VH; const float* x; float* stats;
    __device__ __forceinline__ void operator()(const f32x4 (&acc)[2][2][4][2], const Unit& u, int wr, int wc, int fr, int fq) const {
        const int row0 = u.pm * BM + wr * 64 + fr, col0 = u.pn * BM + wc * 32 + 8 * fq;
#pragma unroll
        EPI_LOOP_AI_M { const size_t row = (size_t)(row0 + ai * HALF + m * 16); float s = 0.f, q = 0.f;
#pragma unroll
            for (int bj = 0; bj < 2; ++bj) { const float* xp = x + row * D + col0 + bj * HALF; const f32x4 x0 = *(const f32x4*)xp, x1 = *(const f32x4*)(xp + 4);
                const f32x4 v0 = x0 * ALPHA + acc[ai][bj][m][0], v1 = x1 * ALPHA + acc[ai][bj][m][1];
                s += (v0[0] + v0[1]) + (v0[2] + v0[3]) + (v1[0] + v1[1]) + (v1[2] + v1[3]);
                q += (v0[0] * v0[0] + v0[1] * v0[1]) + (v0[2] * v0[2] + v0[3] * v0[3]) + (v1[0] * v1[0] + v1[1] * v1[1]) + (v1[2] * v1[2] + v1[3] * v1[3]);
                *(u32x4*)(VH + row * D + col0 + bj * HALF) = pack8(v0, v1); }
            s += __shfl_xor(s, 16); s += __shfl_xor(s, 32); q += __shfl_xor(q, 16); q += __shfl_xor(q, 32);
            if (fq == 0) *(f32x2*)(stats + row * 32 + (u.pn * 4 + wc) * 2) = (f32x2){s, q}; }
    }
};
struct EpiHid {
    bf16_t* HID;
    __device__ __forceinline__ void operator()(const f32x4 (&acc)[2][2][4][2], const Unit& u, int wr, int wc, int fr, int fq) const {
        const int row0 = u.pm * BM + wr * 64 + fr, col0 = u.pn * HALF + wc * 32 + 8 * fq;
#pragma unroll
        EPI_LOOP_AI_M { const size_t row = (size_t)(row0 + ai * HALF + m * 16); f32x4 v0, v1;
#pragma unroll
            for (int j = 0; j < 4; ++j) { const float g0 = acc[ai][0][m][0][j], g1 = acc[ai][0][m][1][j];
                v0[j] = g0 * fast_sigmoid(g0) * acc[ai][1][m][0][j]; v1[j] = g1 * fast_sigmoid(g1) * acc[ai][1][m][1][j]; }
            *(u32x4*)(HID + row * DEXP + col0) = pack8(v0, v1); }
    }
};
struct EpiDown {
    bf16_t* Y; const float* roww;
    __device__ __forceinline__ void operator()(const f32x4 (&acc)[2][2][4][2], const Unit& u, int wr, int wc, int fr, int fq) const {
        const int row0 = u.pm * BM + wr * 64 + fr, col0 = u.pn * BM + wc * 32 + 8 * fq;
#pragma unroll
        EPI_LOOP_AI_M { const size_t row = (size_t)(row0 + ai * HALF + m * 16); const float w = roww[row];
#pragma unroll
            for (int bj = 0; bj < 2; ++bj) *(u32x4*)(Y + row * D + col0 + bj * HALF) = pack8(acc[ai][bj][m][0] * w, acc[ai][bj][m][1] * w); }
    }
};

template <class Epi, class Sched, class Ops, bool ALIGN_EPI>
__device__ __forceinline__ void gemm_phase(PG8_LAS unsigned char* lds, const Ops& G, const Sched& S, const Epi& E) {
    const int tid = opaque_tid(), wid = __builtin_amdgcn_readfirstlane(tid >> 6), lane = tid & 63, wr = wid >> 2, wc = wid & 3, fr = lane & 15, fq = lane >> 4;
    const int K = G.K, nt = K / BK;
    unsigned voffB[2]; int Rr[2], Cc[2];
#pragma unroll
    for (int i = 0; i < 2; ++i) { int R, C; stage_rc(tid * 16 + i * 8192, R, C); const int Rb = (R & ~31) + perm32(R & 31); Rr[i] = R; Cc[i] = C; voffB[i] = (unsigned)(Rb * K + C) * 2u; }
    const size_t kstep = (size_t)(BK * 2);
    const size_t hstepB = (size_t)HALF * K * 2;
    const unsigned ldsw = (unsigned)wid * 1024u;
    const int aoff = lds_byte(wr * 64 + fr, fq * 8), boff = lds_byte(wc * 32 + fr, fq * 8);
#define PG8_SA(b, h) (((b) * 2 + (h)) * HTB)
#define PG8_SB(b, h) ((4 + (b) * 2 + (h)) * HTB)
#define PG8_STAGE(bufoff, gbase, voff) do { _Pragma("unroll") for (int _i = 0; _i < 2; ++_i) \
        __builtin_amdgcn_global_load_lds((const unsigned*)((const char*)(gbase) + (voff)[_i]), (PG8_LAS unsigned*)(lds + (bufoff) + ldsw + _i * 8192), 16, 0, 0); } while (0)
#define PG8_LDA(dst, b, h) do { _Pragma("unroll") for (int m = 0; m < 4; ++m) _Pragma("unroll") for (int k = 0; k < 2; ++k) dst[m][k] = *(const PG8_LAS bf16x8*)(lds + PG8_SA(b, h) + aoff + m * 2048 + k * 1024); } while (0)
#define PG8_LDB(dst, b, h) do { _Pragma("unroll") for (int n = 0; n < 2; ++n) _Pragma("unroll") for (int k = 0; k < 2; ++k) dst[n][k] = *(const PG8_LAS bf16x8*)(lds + PG8_SB(b, h) + boff + n * 2048 + k * 1024); } while (0)
#define PG8_MMA(ai, bj, At, Bt) do { __builtin_amdgcn_s_setprio(1); _Pragma("unroll") for (int m = 0; m < 4; ++m) _Pragma("unroll") for (int n = 0; n < 2; ++n) _Pragma("unroll") for (int k = 0; k < 2; ++k) \
        acc[ai][bj][m][n] = __builtin_amdgcn_mfma_f32_16x16x32_bf16(Bt[n][k], At[m][k], acc[ai][bj][m][n], 0, 0, 0); __builtin_amdgcn_s_setprio(0); } while (0)
#define PG8_WAIT_V(n) asm volatile("s_waitcnt vmcnt(" #n ")" ::: "memory")
#define PG8_WAIT_L(n) asm volatile("s_waitcnt lgkmcnt(" #n ")" ::: "memory")
#define PG8_BAR __builtin_amdgcn_s_barrier()
#define PG8_SCHED __builtin_amdgcn_sched_barrier(0)
    Unit cur, nxt; int ui = 0;
    if (!S.next(0, cur)) return;
    f32x4 acc[2][2][4][2];
#pragma unroll
    for (int a = 0; a < 2; ++a)
#pragma unroll
        for (int b = 0; b < 2; ++b)
#pragma unroll
            for (int m = 0; m < 4; ++m)
#pragma unroll
                for (int n = 0; n < 2; ++n) acc[a][b][m][n] = (f32x4){0.f, 0.f, 0.f, 0.f};
    bf16x8 At[4][2], B0[2][2], B1[2][2];
    unsigned cA0[2], cA1[2], nA0[2], nA1[2];
    G.a_off(cur, Rr, Cc, cA0, cA1);
#pragma unroll
    for (int i = 0; i < 2; ++i) { nA0[i] = cA0[i]; nA1[i] = cA1[i]; }
    const size_t hstepA = Ops::GATHER ? 0 : (size_t)HALF * G.lda * 2;
#define PG8_A1(cur_) (Ops::GATHER ? (cur_##1) : (cur_##0))
    const char* cA = G.a_base(cur); const char* cB = G.b_base(cur);
    PG8_STAGE(PG8_SB(0, 0), cB, voffB); PG8_STAGE(PG8_SB(0, 1), cB + hstepB, voffB); PG8_STAGE(PG8_SA(0, 0), cA, cA0); PG8_STAGE(PG8_SA(0, 1), cA + hstepA, PG8_A1(cA));
    if (wr == 1) PG8_BAR;
    PG8_WAIT_V(2); PG8_BAR;
    PG8_STAGE(PG8_SB(1, 0), cB + kstep, voffB); PG8_STAGE(PG8_SA(1, 0), cA + kstep, cA0); PG8_STAGE(PG8_SB(1, 1), cB + hstepB + kstep, voffB);
    PG8_WAIT_V(6); PG8_BAR;
    for (;;) {
        const bool has_next = S.next(ui + 1, nxt);
        const char* nA = has_next ? G.a_base(nxt) : cA; const char* nB = has_next ? G.b_base(nxt) : cB;
        for (int t = 0; t < nt; t += 2) {
            const bool last = (t == nt - 2);
            const char* a1 = cA + (size_t)(t + 1) * kstep;
            const char* a2 = last ? nA : cA + (size_t)(t + 2) * kstep; const char* b2 = last ? nB : cB + (size_t)(t + 2) * kstep;
            const char* a3 = a2 + kstep; const char* b3 = b2 + kstep;
            unsigned xA0[2], xA1[2];
            if constexpr (Ops::GATHER) { if (last && has_next) G.a_off(nxt, Rr, Cc, nA0, nA1);
#pragma unroll
                for (int i = 0; i < 2; ++i) { xA0[i] = last ? nA0[i] : cA0[i]; xA1[i] = last ? nA1[i] : cA1[i]; } }
            else {
#pragma unroll
                for (int i = 0; i < 2; ++i) { xA0[i] = cA0[i]; xA1[i] = cA0[i]; } }
            PG8_LDB(B0, 0, 0); PG8_LDB(B1, 0, 1); PG8_SCHED; PG8_LDA(At, 0, 0); PG8_STAGE(PG8_SA(1, 1), a1 + hstepA, PG8_A1(cA));
            PG8_WAIT_V(8); PG8_WAIT_L(0); PG8_BAR; PG8_MMA(0, 0, At, B0); PG8_MMA(0, 1, At, B1); PG8_BAR; PG8_SCHED;
            PG8_LDA(At, 0, 1); PG8_STAGE(PG8_SB(0, 0), b2, voffB); PG8_STAGE(PG8_SB(0, 1), b2 + hstepB, voffB); PG8_STAGE(PG8_SA(0, 0), a2, xA0);
            PG8_WAIT_V(8); PG8_WAIT_L(0); PG8_BAR; PG8_MMA(1, 0, At, B0); PG8_MMA(1, 1, At, B1); PG8_BAR; PG8_SCHED;
            PG8_LDB(B0, 1, 0); PG8_LDB(B1, 1, 1); PG8_SCHED; PG8_LDA(At, 1, 0); PG8_STAGE(PG8_SA(0, 1), a2 + hstepA, xA1);
            PG8_WAIT_V(8); PG8_WAIT_L(0); PG8_BAR; PG8_MMA(0, 0, At, B0); PG8_MMA(0, 1, At, B1); PG8_BAR; PG8_SCHED;
            PG8_LDA(At, 1, 1); PG8_STAGE(PG8_SB(1, 0), b3, voffB); PG8_STAGE(PG8_SB(1, 1), b3 + hstepB, voffB); PG8_STAGE(PG8_SA(1, 0), a3, xA0);
            PG8_WAIT_V(8); PG8_WAIT_L(0); PG8_BAR; PG8_MMA(1, 0, At, B0); PG8_MMA(1, 1, At, B1); PG8_BAR; PG8_SCHED;
        }
        if constexpr (ALIGN_EPI) { if (wr == 0) PG8_BAR; }
        E(acc, cur, wr, wc, fr, fq);
        if (!has_next) break;
#pragma unroll
        for (int a = 0; a < 2; ++a)
#pragma unroll
            for (int b = 0; b < 2; ++b)
#pragma unroll
                for (int m = 0; m < 4; ++m)
#pragma unroll
                    for (int n = 0; n < 2; ++n) acc[a][b][m][n] = (f32x4){0.f, 0.f, 0.f, 0.f};
        cur = nxt; cA = nA; cB = nB; ++ui;
#pragma unroll
        for (int i = 0; i < 2; ++i) { cA0[i] = nA0[i]; cA1[i] = nA1[i]; }
        if constexpr (ALIGN_EPI) { if (wr == 1) PG8_BAR; }
    }
    PG8_WAIT_V(0);
    if constexpr (!ALIGN_EPI) { if (wr == 0) PG8_BAR; }
    PG8_BAR;
#undef PG8_SA
#undef PG8_A1
#undef PG8_SB
#undef PG8_STAGE
#undef PG8_LDA
#undef PG8_LDB
#undef PG8_MMA
#undef PG8_WAIT_V
#undef PG8_WAIT_L
#undef PG8_BAR
#undef PG8_SCHED
}
}

namespace attn {
constexpr int KBUF = 12288, VBUF = 8192;
constexpr int LDS_K = 0, LDS_V = 2 * KBUF, LDS_WS = LDS_V + 2 * VBUF, LDS_OST = LDS_WS + 8 * 256, LDS_BYTES = LDS_OST + 8 * 4096;
typedef LAS const char* lds_cptr;
__device__ __forceinline__ int crow(int r, int hi) { return (r & 3) + 8 * (r >> 2) + 4 * hi; }
__device__ __forceinline__ float max3f(float a, float b, float c) { return __builtin_fmaxf(__builtin_fmaxf(a, b), c); }
__device__ __forceinline__ float rowmax(const f32x16& p0, const f32x16& p1) {
    float a = max3f(p0[0], p0[1], p1[0]), b = max3f(p0[2], p0[3], p1[1]); a = max3f(a, p1[2], p1[3]);
#pragma unroll
    for (int r = 4; r < 16; r += 4) { a = max3f(a, p0[r], p0[r + 1]); b = max3f(b, p0[r + 2], p0[r + 3]); a = max3f(a, p1[r], p1[r + 1]); b = max3f(b, p1[r + 2], p1[r + 3]); }
    const float m = __builtin_fmaxf(a, b);
    auto rr = __builtin_amdgcn_permlane32_swap(__float_as_uint(m), __float_as_uint(m), false, false);
    return __builtin_fmaxf(__uint_as_float(rr[0]), __uint_as_float(rr[1]));
}
__device__ __forceinline__ unsigned cvtpk(float lo, float hi) { unsigned r; asm volatile("v_cvt_pk_bf16_f32 %0, %1, %2" : "=v"(r) : "v"(lo), "v"(hi)); return r; }

template <int THRL> __device__ __forceinline__ void attn_unit(int b, int h, int qb, const bf16* Q, const bf16* __restrict__ K, const bf16* __restrict__ V, bf16* O, LAS unsigned char* shm) {
    const int tid = opaque_tid(), lane = tid & 63, r32 = lane & 31, hi = lane >> 5; const int wid = __builtin_amdgcn_readfirstlane(tid >> 6);
    const size_t rowbase = (size_t)b * SEQ; const int q0 = qb * 256;
    const bf16* Qw = Q + (rowbase + q0 + wid * 32) * QP + h * QKD;
    const bf16* Kh = K + rowbase * QP + h * QKD; const bf16* Vh = V + rowbase * 512 + h * VD;
    LAS float* wsf = (LAS float*)(shm + LDS_WS) + wid * 64;
    const int NT = 4 * qb + 4, my_nt = 4 * qb + (wid >> 1) + 1;
#define ATT_GLDS(src, dstoff) __builtin_amdgcn_global_load_lds((const unsigned*)(src), (LAS unsigned*)(shm + (dstoff)), 16, 0, 0)
#define ATT_DMA(t, buf) do { const bf16* ks_ = Kh + (size_t)((t) * 64 + lane) * QP; \
        ATT_GLDS(ks_ + wid * 8, LDS_K + (buf) * KBUF + wid * 1024); \
        if (wid < 4) ATT_GLDS(ks_ + (wid + 8) * 8, LDS_K + (buf) * KBUF + (wid + 8) * 1024); \
        ATT_GLDS(Vh + (size_t)((t) * 64 + 16 * (wid & 3) + (lane >> 2)) * 512 + (wid >> 2) * 32 + (lane & 3) * 8, LDS_V + (buf) * VBUF + wid * 1024); } while (0)
    ATT_DMA(0, 0);
    bf16x8 qr[6];
#pragma unroll
    for (int d0 = 0; d0 < 6; ++d0) qr[d0] = *reinterpret_cast<const bf16x8*>(&Qw[(size_t)r32 * QP + d0 * 16 + hi * 8]);
    float mrow = -1e30f, l_reg = 0.f; f32x16 o[2]; o[0] = f32x16{}; o[1] = f32x16{};
    const int vboff = ((lane >> 4) & 1) * 32 + (lane & 3) * 8 + (4 * hi + ((lane & 15) >> 2)) * 64;
    for (int t = 0; t < NT; ++t) {
        asm volatile("s_waitcnt vmcnt(0)" ::: "memory");
        __syncthreads();
        if (t + 1 < NT) ATT_DMA(t + 1, (t + 1) & 1);
        if (t < my_nt) {
            const int buf = t & 1;
            f32x16 p0 = f32x16{}, p1 = f32x16{};
            { lds_cptr kb = (lds_cptr)(shm + LDS_K + buf * KBUF) + hi * 1024 + r32 * 16;
#pragma unroll
              for (int d0 = 0; d0 < 6; ++d0) { const bf16x8 b0 = *(const LAS bf16x8*)(kb + d0 * 2048), b1 = *(const LAS bf16x8*)(kb + d0 * 2048 + 512);
                  p0 = __builtin_amdgcn_mfma_f32_32x32x16_bf16(b0, qr[d0], p0, 0, 0, 0); p1 = __builtin_amdgcn_mfma_f32_32x32x16_bf16(b1, qr[d0], p1, 0, 0, 0); } }
            const float rm = rowmax(p0, p1);
            if (__any(rm > mrow + (float)THRL)) {
                const float mn = __builtin_fmaxf(mrow, rm); const float f = __builtin_amdgcn_exp2f(mrow - mn); l_reg *= f; mrow = mn;
                if (hi == 0) wsf[r32] = f;
                asm volatile("s_waitcnt lgkmcnt(0)" ::: "memory");
#pragma unroll
                for (int d_ = 0; d_ < 2; ++d_)
#pragma unroll
                    for (int r = 0; r < 16; ++r) o[d_][r] *= wsf[crow(r, hi)];
            }
            float sacc = 0.f;
#pragma unroll
            for (int r = 0; r < 16; ++r) { p0[r] = __builtin_amdgcn_exp2f(p0[r] - mrow); p1[r] = __builtin_amdgcn_exp2f(p1[r] - mrow); sacc += p0[r] + p1[r]; }
            l_reg += sacc;
            v4u pw0, pw1, pw2, pw3;
            pw0 = (v4u){cvtpk(p0[0], p0[1]), cvtpk(p0[2], p0[3]), cvtpk(p0[4], p0[5]), cvtpk(p0[6], p0[7])};
            pw1 = (v4u){cvtpk(p0[8], p0[9]), cvtpk(p0[10], p0[11]), cvtpk(p0[12], p0[13]), cvtpk(p0[14], p0[15])};
            pw2 = (v4u){cvtpk(p1[0], p1[1]), cvtpk(p1[2], p1[3]), cvtpk(p1[4], p1[5]), cvtpk(p1[6], p1[7])};
            pw3 = (v4u){cvtpk(p1[8], p1[9]), cvtpk(p1[10], p1[11]), cvtpk(p1[12], p1[13]), cvtpk(p1[14], p1[15])};
            { const int vb = (int)(uintptr_t)(shm + LDS_V + buf * VBUF) + vboff;
#pragma unroll
              for (int d0 = 0; d0 < 2; ++d0) { s16x4 lo[4], hh[4];
#pragma unroll
                  for (int ks = 0; ks < 4; ++ks) {
                      asm volatile("ds_read_b64_tr_b16 %0,%1 offset:%c2" : "=&v"(lo[ks]) : "v"(vb), "i"(d0 * 4096 + ks * 1024) : "memory");
                      asm volatile("ds_read_b64_tr_b16 %0,%1 offset:%c2" : "=&v"(hh[ks]) : "v"(vb), "i"(d0 * 4096 + ks * 1024 + 512) : "memory"); }
                  asm volatile("s_waitcnt lgkmcnt(0)" ::: "memory"); __builtin_amdgcn_sched_barrier(0);
#define ATT_PK(k) (bf16x8){lo[k][0], lo[k][1], lo[k][2], lo[k][3], hh[k][0], hh[k][1], hh[k][2], hh[k][3]}
                  o[d0] = __builtin_amdgcn_mfma_f32_32x32x16_bf16(__builtin_bit_cast(bf16x8, pw0), ATT_PK(0), o[d0], 0, 0, 0);
                  o[d0] = __builtin_amdgcn_mfma_f32_32x32x16_bf16(__builtin_bit_cast(bf16x8, pw1), ATT_PK(1), o[d0], 0, 0, 0);
                  o[d0] = __builtin_amdgcn_mfma_f32_32x32x16_bf16(__builtin_bit_cast(bf16x8, pw2), ATT_PK(2), o[d0], 0, 0, 0);
                  o[d0] = __builtin_amdgcn_mfma_f32_32x32x16_bf16(__builtin_bit_cast(bf16x8, pw3), ATT_PK(3), o[d0], 0, 0, 0);
#undef ATT_PK
              } }
        }
    }
    { auto rr = __builtin_amdgcn_permlane32_swap(__float_as_uint(l_reg), __float_as_uint(l_reg), false, false); l_reg = __uint_as_float(rr[0]) + __uint_as_float(rr[1]); }
    if (hi == 0) wsf[32 + r32] = l_reg;
    asm volatile("s_waitcnt lgkmcnt(0)" ::: "memory");
    float rli[16];
#pragma unroll
    for (int r = 0; r < 16; ++r) rli[r] = __builtin_amdgcn_rcpf(wsf[32 + crow(r, hi)]);
    bf16* Ow = O + (rowbase + q0 + wid * 32) * 512 + h * VD;
    { LAS bf16* stg = (LAS bf16*)(shm + LDS_OST) + wid * 2048;
#pragma unroll
      for (int r = 0; r < 16; ++r) { const int orow = crow(r, hi);
#pragma unroll
          for (int d0 = 0; d0 < 2; ++d0) stg[orow * 64 + d0 * 32 + r32] = (bf16)f2bf(o[d0][r] * rli[r]); }
      asm volatile("s_waitcnt lgkmcnt(0)" ::: "memory");
#pragma unroll
      for (int i = 0; i < 4; ++i) { const int row = i * 8 + (lane >> 3), ch = lane & 7; const v4u v = *(const LAS v4u*)(stg + row * 64 + ch * 8); *(v4u*)(Ow + (size_t)row * 512 + ch * 8) = v; } }
    asm volatile("s_waitcnt lgkmcnt(0)" ::: "memory");
#undef ATT_GLDS
#undef ATT_DMA
}
}

#define XB_TMO      128
#define XB_XCNT(j)  (256  + 64 * (j))
#define XB_XSUB(j)  (1280 + 64 * (j))
#define XB_XGEN(j)  (2304 + 64 * (j))
#define XB_TOP      3328
#define XB_TOPGEN   3392
#define XCD_BAR_WORDS 3456
#define XB_SPIN_CAP (1u << 22)

__device__ __forceinline__ unsigned xb_ld(unsigned* p)              { return __hip_atomic_load(p, __ATOMIC_RELAXED, __HIP_MEMORY_SCOPE_AGENT); }
__device__ __forceinline__ unsigned xb_add(unsigned* p, unsigned v) { return __hip_atomic_fetch_add(p, v, __ATOMIC_RELAXED, __HIP_MEMORY_SCOPE_AGENT); }
__device__ __forceinline__ unsigned xb_xcc_id() { return (unsigned)__builtin_amdgcn_s_getreg((3 << 11) | 20) & 0xFu; }
#define XB_SPIN(cond, bar) do { unsigned _sp = 0; while (cond) { __builtin_amdgcn_s_sleep(1); \
    if ((++_sp & 255u) == 0u) { if (xb_ld(&(bar)[XB_TMO])) break; if (_sp > XB_SPIN_CAP) { atomicAdd(&(bar)[XB_TMO], 1u); break; } } } } while (0)

struct XcdBarrier { unsigned* bar; unsigned x; volatile LAS unsigned* st; };
__device__ __forceinline__ XcdBarrier xcd_barrier_post(unsigned* bar, volatile LAS unsigned* st) {
    XcdBarrier b; b.bar = bar; b.x = xb_xcc_id(); b.st = st;
    if (threadIdx.x == 0) (void)xb_add(&bar[XB_XCNT(b.x)], 1u);
    return b;
}
__device__ __forceinline__ void xcd_barrier_complete(unsigned* bar, unsigned x, unsigned& nloc, unsigned& nx) {
    const unsigned G = gridDim.x * gridDim.y * gridDim.z;
    unsigned sum, cnt, mine, sp = 0u;
    for (;;) {
        sum = 0u; cnt = 0u; mine = 0u;
#pragma unroll
        for (unsigned j = 0; j < 16; ++j) { const unsigned c = xb_ld(&bar[XB_XCNT(j)]); sum += c; cnt += (c > 0u) ? 1u : 0u; mine = (j == x) ? c : mine; }
        if (sum == G) break;
        __builtin_amdgcn_s_sleep(1);
        if ((++sp & 255u) == 0u) { if (xb_ld(&bar[XB_TMO])) break; if (sp > XB_SPIN_CAP) { atomicAdd(&bar[XB_TMO], 1u); break; } }
    }
    nloc = mine > 0u ? mine : 1u; nx = cnt > 0u ? cnt : 1u;
}
__device__ __forceinline__ void xcd_barrier(const XcdBarrier& b) {
    asm volatile("s_waitcnt vmcnt(0)" ::: "memory");
    __syncthreads();
    if (threadIdx.x == 0) {
        unsigned* bar = b.bar;
        __builtin_amdgcn_s_waitcnt(0);
        unsigned nloc = b.st[0], nx = b.st[1];
        if (nloc == 0u) { xcd_barrier_complete(bar, b.x, nloc, nx); b.st[0] = nloc; b.st[1] = nx; }
        const unsigned old = xb_add(&bar[XB_XSUB(b.x)], 1u);
        const unsigned gen = old / nloc;
        if (old + 1u == (gen + 1u) * nloc) {
            __builtin_amdgcn_fence(__ATOMIC_RELEASE, "agent");
            asm volatile("s_waitcnt vmcnt(0)" ::: "memory");
            const unsigned og = xb_add(&bar[XB_TOP], 1u);
            const unsigned tg = og / nx;
            if (og + 1u == (tg + 1u) * nx) xb_add(&bar[XB_TOPGEN], 1u);
            else XB_SPIN(xb_ld(&bar[XB_TOPGEN]) == tg, bar);
            __builtin_amdgcn_fence(__ATOMIC_ACQUIRE, "agent");
            xb_add(&bar[XB_XGEN(b.x)], 1u);
            asm volatile("s_waitcnt vmcnt(0)" ::: "memory");
        } else {
            XB_SPIN(xb_ld(&bar[XB_XGEN(b.x)]) == gen, bar);
            __builtin_amdgcn_fence(__ATOMIC_ACQUIRE, "agent");
            asm volatile("s_waitcnt vmcnt(0)" ::: "memory");
        }
    }
    __syncthreads();
}

constexpr int NWAVES = 8;
struct Params {
    const float* in[21];
    float* out; unsigned char* ws;
    int ph_lo, ph_hi;
};
struct Frame {
    LAS unsigned char* lds; volatile LAS unsigned* MISC;
    int tid, lane, wave, vcu, G;
    unsigned char* ws; unsigned char* outb;
};

__device__ __forceinline__ void frame_ids(Frame& F) { F.tid = opaque_tid(); F.lane = F.tid & 63; F.wave = __builtin_amdgcn_readfirstlane(F.tid >> 6); }
__device__ __forceinline__ int il32(int j) { return j < 16 ? 2 * j : 2 * (j - 16) + 1; }
__device__ __forceinline__ int maprow(int kind, int n) {
    switch (kind) {
    case 1: return n < C_KPE ? n : (n < C_KPE + 32 ? C_KPE + il32(n - C_KPE) : n + 96);
    case 2: { const int h = n / 96, j = n - h * 96; return j < 64 ? h * 64 + j : 512 + h * 32 + il32(j - 64); }
    case 3: { const int h = n >> 7, j = n & 127; return j < 64 ? h * 64 + j : 512 + h * 64 + (j - 64); }
    case 4: return (n >> 7) * 256 + (n & 127);
    case 5: return (n >> 7) * 256 + 128 + (n & 127);
    default: return n; }
}
__device__ __forceinline__ void p0_transpose_item(const float* W, int K, int N, bf16* WT, const float* kscale, int kind, LAS float* scr, int item, int lane) {
    const int nblk = N / 32, kb = item / nblk, nb = item % nblk, k0 = 64 * kb, n0 = 32 * nb;
#pragma unroll 8
    for (int i = 0; i < 32; ++i) { const int kk = 2 * i + (lane >> 5); float v = W[(size_t)(k0 + kk) * N + n0 + (lane & 31)]; if (kscale) v *= kscale[k0 + kk]; scr[kk * 33 + (lane & 31)] = v; }
    LDS_WAIT(); asm volatile("" ::: "memory");
    const int c = lane & 7;
#pragma unroll
    for (int j = 0; j < 4; ++j) { const int n = (lane >> 3) + 8 * j; const LAS float* s = scr + (8 * c) * 33 + n;
        v4u o; o.x = pk2(s[0 * 33], s[1 * 33]); o.y = pk2(s[2 * 33], s[3 * 33]); o.z = pk2(s[4 * 33], s[5 * 33]); o.w = pk2(s[6 * 33], s[7 * 33]);
        *(GAS v4u*)(WT + (size_t)maprow(kind, n0 + n) * K + k0 + 8 * c) = o; }
    LDS_WAIT(); asm volatile("" ::: "memory");
}
__device__ __forceinline__ void p0_prologue(Frame& F, const Params& P) {
    LAS float* scr = (LAS float*)(F.lds + RING_OFF + F.wave * 16384);
    const int gw = F.vcu * NWAVES + F.wave, NGW = F.G * NWAVES;
    unsigned char* ws = F.ws;
    constexpr int I_IN = 16 * 101, I_POOL = 64, I_UQ = 6 * 24, I_UKV = 4 * 32, I_MLAO = 8 * 32, I_OUT = 16 * 32, I_GE = 16 * 16, I_G = 32 * I_GE, I_DE = 8 * 32, I_D = 32 * I_DE;
    constexpr int NITEMS = I_IN + I_POOL + I_UQ + I_UKV + I_MLAO + I_OUT + 2 * I_G + I_D;
    for (int it = gw; it < NITEMS; it += NGW) {
        int r = it;
        if (r < I_IN) { p0_transpose_item(P.in[1], 1024, 3232, (bf16*)(ws + W_IN_T), nullptr, 1, scr, r, F.lane); continue; } r -= I_IN;
        if (r < I_POOL) { const int g = r >> 4; p0_transpose_item(P.in[2] + (size_t)g * 128 * 256, 128, 256, (bf16*)(ws + W_POOL_T) + (size_t)g * 256 * 128, nullptr, 0, scr, r & 15, F.lane); continue; } r -= I_POOL;
        if (r < I_UQ) { p0_transpose_item(P.in[5], 384, 768, (bf16*)(ws + W_UQ_T), P.in[4], 2, scr, r, F.lane); continue; } r -= I_UQ;
        if (r < I_UKV) { p0_transpose_item(P.in[7], 256, 1024, (bf16*)(ws + W_UKV_T), P.in[6], 3, scr, r, F.lane); continue; } r -= I_UKV;
        if (r < I_MLAO) { p0_transpose_item(P.in[8], 512, 1024, (bf16*)(ws + W_MLAO_T), nullptr, 0, scr, r, F.lane); continue; } r -= I_MLAO;
        if (r < I_OUT) { p0_transpose_item(P.in[9], 1024, 1024, (bf16*)(ws + W_OUT_T), nullptr, 0, scr, r, F.lane); continue; } r -= I_OUT;
        if (r < I_G) { const int e = r / I_GE; p0_transpose_item(P.in[16] + (size_t)e * 1024 * 512, 1024, 512, (bf16*)(ws + W_GU_T) + (size_t)e * 1024 * 1024, nullptr, 4, scr, r % I_GE, F.lane); continue; } r -= I_G;
        if (r < I_G) { const int e = r / I_GE; p0_transpose_item(P.in[17] + (size_t)e * 1024 * 512, 1024, 512, (bf16*)(ws + W_GU_T) + (size_t)e * 1024 * 1024, nullptr, 5, scr, r % I_GE, F.lane); continue; } r -= I_G;
        { const int e = r / I_DE; p0_transpose_item(P.in[18] + (size_t)e * 512 * 1024, 512, 1024, (bf16*)(ws + W_DN_T) + (size_t)e * 1024 * 512, nullptr, 0, scr, r % I_DE, F.lane); }
    }
    const int gt = (F.vcu * NWAVES + F.wave) * 64 + F.lane, NGT = NGW * 64;
    for (int i = gt; i < 96 * 1024 / 8; i += NGT) *(GAS v4u*)((bf16*)(ws + W_IN_T) + (size_t)1184 * 1024 + (size_t)i * 8) = (v4u){0u, 0u, 0u, 0u};
    for (int i = gt; i < 48 * 1024; i += NGT) { const int c = i >> 10, k = i & 1023; float v = 0.f; if (c < 4) v = P.in[12][k * 4 + c]; else if (c < 36) v = P.in[14][k * 32 + (c - 4)];
        ((bf16*)(ws + W_ROUTER_T))[i] = (bf16)f2bf(v); }
    for (int i = gt; i < SEQ * 16; i += NGT) { const int pos = i >> 4, p = i & 15; const float inv = 1.0f / powf(10000.0f, (float)(2 * p) / 32.0f); const float ang = (float)pos * inv;
        const double rev = (double)ang * 0.15915494309189533577; const float fr = (float)(rev - floor(rev));
        ((f32x2*)(ws + SM_ROPE))[i] = (f32x2){__builtin_amdgcn_cosf(fr), __builtin_amdgcn_sinf(fr)}; }
    { const float* x = P.in[0]; bf16* xb = (bf16*)(ws + WS_XB);
      for (int i = gt; i < M * D / 8; i += NGT) { const f32x4 a = *(const GAS f32x4*)(x + (size_t)i * 8), b = *(const GAS f32x4*)(x + (size_t)i * 8 + 4);
          v4u o; o.x = pk2(a.x, a.y); o.y = pk2(a.z, a.w); o.z = pk2(b.x, b.y); o.w = pk2(b.z, b.w); *(GAS v4u*)(xb + (size_t)i * 8) = o; } }
}

__device__ __forceinline__ void unpack8f(const v4u& w, float (&f)[8]) { f[0] = bflo(w.x); f[1] = bfhi(w.x); f[2] = bflo(w.y); f[3] = bfhi(w.y); f[4] = bflo(w.z); f[5] = bfhi(w.z); f[6] = bflo(w.w); f[7] = bfhi(w.w); }
__device__ __forceinline__ void p2_thin(Frame& F) {
    const bf16* PB = (const bf16*)(F.ws + WS_PB); bf16* pooled = (bf16*)(F.ws + WS_POOLED); bf16* Kf = (bf16*)(F.ws + WS_K);
    float* rq = (float*)(F.ws + SM_RQ); float* rkv = (float*)(F.ws + SM_RKV); const f32x2* rope = (const f32x2*)(F.ws + SM_ROPE);
    const int l = F.lane;
    for (int blk = blockIdx.x; blk < M / 128; blk += F.G) {
        const int t0 = blk * 128 + F.wave * 16, pos0 = t0 & (SEQ - 1);
        { const int g = l >> 4, W = 2 << g; const bf16* up = PB + (size_t)t0 * PBW + 8 * l;
          float sum[8];
#pragma unroll
          for (int j = 0; j < 8; ++j) sum[j] = 0.f;
#pragma unroll
          for (int j = 1; j < 16; ++j) { if (j < W && pos0 - j >= 0) { const v4u w = *(const GAS v4u*)(up - (ptrdiff_t)j * PBW); float f[8]; unpack8f(w, f);
#pragma unroll
                  for (int e = 0; e < 8; ++e) sum[e] += f[e]; } }
#pragma unroll 4
          for (int i = 0; i < 16; ++i) { const v4u cw = *(const GAS v4u*)(up + (size_t)i * PBW); float cur[8]; unpack8f(cw, cur);
              const int pos = pos0 + i; const int cnt = (pos + 1 < W) ? pos + 1 : W; const float inv = 1.0f / (float)cnt; float o[8];
#pragma unroll
              for (int e = 0; e < 8; ++e) { sum[e] += cur[e]; o[e] = sum[e] * inv - cur[e]; }
              v4u ow; ow.x = pk2(o[0], o[1]); ow.y = pk2(o[2], o[3]); ow.z = pk2(o[4], o[5]); ow.w = pk2(o[6], o[7]);
              *(GAS v4u*)(pooled + (size_t)(t0 + i) * 512 + 8 * l) = ow;
              if (pos - W + 1 >= 0) { const v4u w = *(const GAS v4u*)(up + (ptrdiff_t)(i - W + 1) * PBW); float f[8]; unpack8f(w, f);
#pragma unroll
                  for (int e = 0; e < 8; ++e) sum[e] -= f[e]; } } }
        for (int i = 0; i < 16; ++i) { const int t = t0 + i; const bf16* row = PB + (size_t)t * PBW; float sq = 0.f, sk = 0.f;
            if (l < 48) { const v4u w = *(const GAS v4u*)(row + C_CQ + 8 * l); float f[8]; unpack8f(w, f);
#pragma unroll
                for (int e = 0; e < 8; ++e) sq += f[e] * f[e]; }
            if (l < 32) { const v4u w = *(const GAS v4u*)(row + C_CKV + 8 * l); float f[8]; unpack8f(w, f);
#pragma unroll
                for (int e = 0; e < 8; ++e) sk += f[e] * f[e]; }
            sq = wave_sum(sq); sk = wave_sum(sk);
            if (l == 0) { rq[t] = 1.0f / sqrtf(sq * (1.0f / 384.0f) + EPS); rkv[t] = 1.0f / sqrtf(sk * (1.0f / 256.0f) + EPS); }
            if (l < 16) { const unsigned w = *(const GAS unsigned*)(row + C_KPE + 2 * l); const float x1 = bflo(w), x2 = bfhi(w); const f32x2 cs = rope[(size_t)(t & (SEQ - 1)) * 16 + l];
                const unsigned ow = pk2(x1 * cs.x - x2 * cs.y, x1 * cs.y + x2 * cs.x);
#pragma unroll
                for (int h = 0; h < NH; ++h) *(GAS unsigned*)(Kf + (size_t)t * QP + h * QKD + 64 + 2 * l) = ow; } }
    }
}

__device__ __forceinline__ void p7_ln_router(Frame& F, const Params& P) {
    bf16* VH = (bf16*)(F.ws + WS_VH); const float* stats = (const float*)(F.ws + SM_STATS); const bf16* RT = (const bf16*)(F.ws + W_ROUTER_T);
    v4u* recs = (v4u*)(F.ws + SM_RECS); int* blkcnt = (int*)(F.ws + SM_BLKCNT);
    const float* g1 = P.in[10]; const float* b1 = P.in[11]; const float* brg = P.in[13]; const float* bre = P.in[15];
    LAS float* lg = (LAS float*)(F.lds + F.wave * 3072); LAS unsigned* hist = (LAS unsigned*)(F.lds + 32768);
    const int l = F.lane, r = l & 15, q = l >> 4;
    for (int blk = blockIdx.x; blk < M / 128; blk += F.G) {
        if (F.tid < 32) hist[F.tid] = 0u;
        __syncthreads();
        const int t = blk * 128 + F.wave * 16 + r;
        float mean, rstd;
        { const float* st = stats + (size_t)t * 32 + q * 8; const f32x4 a = *(const GAS f32x4*)st, b = *(const GAS f32x4*)(st + 4);
          float s = (a.x + a.z) + (b.x + b.z), qq = (a.y + a.w) + (b.y + b.w);
          s += __shfl_xor(s, 16); s += __shfl_xor(s, 32); qq += __shfl_xor(qq, 16); qq += __shfl_xor(qq, 32);
          mean = s * (1.0f / 1024.0f); const float var = qq * (1.0f / 1024.0f) - mean * mean; rstd = 1.0f / sqrtf(var + EPS); }
        f32x4 acc[3]; acc[0] = (f32x4){0.f, 0.f, 0.f, 0.f}; acc[1] = acc[0]; acc[2] = acc[0];
        bf16* vrow = VH + (size_t)t * D;
#pragma unroll 2
        for (int s_ = 0; s_ < 32; ++s_) { const int c0 = 32 * s_ + 8 * q;
            const v4u w = *(const GAS v4u*)(vrow + c0); float f[8]; unpack8f(w, f);
            const f32x4 ga = *(const GAS f32x4*)(g1 + c0), gb = *(const GAS f32x4*)(g1 + c0 + 4), ba = *(const GAS f32x4*)(b1 + c0), bb = *(const GAS f32x4*)(b1 + c0 + 4);
            float hv[8];
#pragma unroll
            for (int e = 0; e < 4; ++e) { hv[e] = (f[e] - mean) * rstd * ga[e] + ba[e]; hv[4 + e] = (f[4 + e] - mean) * rstd * gb[e] + bb[e]; }
            v4u hw; hw.x = pk2(hv[0], hv[1]); hw.y = pk2(hv[2], hv[3]); hw.z = pk2(hv[4], hv[5]); hw.w = pk2(hv[6], hv[7]);
            *(GAS v4u*)(vrow + c0) = hw;
            const bf16x8 af = __builtin_bit_cast(bf16x8, hw);
#pragma unroll
            for (int ct = 0; ct < 3; ++ct) { const bf16x8 bfr = *(const GAS bf16x8*)(RT + (size_t)(16 * ct + r) * D + c0); acc[ct] = __builtin_amdgcn_mfma_f32_16x16x32_bf16(af, bfr, acc[ct], 0, 0, 0); } }
#pragma unroll
        for (int ct = 0; ct < 3; ++ct)
#pragma unroll
            for (int j = 0; j < 4; ++j) lg[(4 * q + j) * 48 + 16 * ct + r] = acc[ct][j];
        LDS_WAIT(); asm volatile("" ::: "memory");
        if (l < 16) { const LAS float* lp = lg + l * 48; const int tok = blk * 128 + F.wave * 16 + l;
            float gl[4];
#pragma unroll
            for (int j = 0; j < 4; ++j) gl[j] = lp[j] + brg[j];
            int gi = 0; float gm = gl[0];
#pragma unroll
            for (int j = 1; j < 4; ++j) if (gl[j] > gm) { gm = gl[j]; gi = j; }
            float gs = 0.f;
#pragma unroll
            for (int j = 0; j < 4; ++j) gs += __expf(gl[j] - gm);
            const float gw_ = 1.0f / gs;
            float el[8];
#pragma unroll
            for (int j = 0; j < 8; ++j) el[j] = lp[4 + 8 * gi + j] + bre[8 * gi + j];
            int i1 = 0; float m1 = el[0];
#pragma unroll
            for (int j = 1; j < 8; ++j) if (el[j] > m1) { m1 = el[j]; i1 = j; }
            int i2 = -1; float m2 = -3.0e38f;
#pragma unroll
            for (int j = 0; j < 8; ++j) if (j != i1 && el[j] > m2) { m2 = el[j]; i2 = j; }
            const float p2 = __expf(m2 - m1), den = 1.0f / (1.0f + p2);
            const float w1 = gw_ * den, w2 = gw_ * p2 * den; const int e1 = 8 * gi + i1, e2 = 8 * gi + i2;
            recs[tok] = (v4u){(unsigned)e1, (unsigned)e2, __float_as_uint(w1), __float_as_uint(w2)};
            atomicAdd((unsigned*)&hist[e1], 1u); atomicAdd((unsigned*)&hist[e2], 1u); }
        __syncthreads();
        if (F.tid < 32) blkcnt[blk * 32 + F.tid] = (int)hist[F.tid];
        __syncthreads();
    }
}

__device__ __forceinline__ void p8_scatter(Frame& F) {
    const v4u* recs = (const v4u*)(F.ws + SM_RECS); const int* blkcnt = (const int*)(F.ws + SM_BLKCNT);
    int* row_tok = (int*)(F.ws + SM_ROWTOK); float* row_w = (float*)(F.ws + SM_ROWW); int* rowof = (int*)(F.ws + SM_ROWOF); int* pinfo = (int*)(F.ws + SM_PINFO);
    LAS int* part_tot = (LAS int*)(F.lds);
    LAS int* part_pre = (LAS int*)(F.lds + 2048);
    LAS int* cnt = (LAS int*)(F.lds + 4096);
    LAS int* base = (LAS int*)(F.lds + 4224);
    LAS int* pstart = (LAS int*)(F.lds + 4352);
    LAS int* exps = (LAS int*)(F.lds + 4608);
    const int nblk = M / 128;
    for (int blk = blockIdx.x; blk < nblk; blk += F.G) {
        { const int e = F.tid & 31, part = F.tid >> 5; int tot = 0, pre = 0;
          for (int b = part * 16; b < part * 16 + 16; ++b) { const int c = blkcnt[b * 32 + e]; tot += c; if (b < blk) pre += c; }
          part_tot[part * 32 + e] = tot; part_pre[part * 32 + e] = pre; }
        __syncthreads();
        if (F.tid < 32) { int tot = 0, pre = 0;
#pragma unroll
            for (int p = 0; p < 16; ++p) { tot += part_tot[p * 32 + F.tid]; pre += part_pre[p * 32 + F.tid]; }
            cnt[F.tid] = tot; base[F.tid] = pre; }
        __syncthreads();
        if (F.tid == 0) { int s = 0; for (int e = 0; e < 32; ++e) { pstart[e] = s; s += (cnt[e] + 255) & ~255; } pstart[32] = s; }
        __syncthreads();
        int e_a = 0, tok = 0, k = 0; float w_a = 0.f;
        if (F.tid < 256) { tok = blk * 128 + (F.tid >> 1); k = F.tid & 1; const v4u rc = recs[tok]; e_a = (int)(k ? rc.y : rc.x); w_a = __uint_as_float(k ? rc.w : rc.z); exps[F.tid] = e_a; }
        __syncthreads();
        if (F.tid < 256) { int rank = 0; for (int a = 0; a < F.tid; ++a) rank += (exps[a] == e_a) ? 1 : 0;
            const int dest = pstart[e_a] + base[e_a] + rank; row_tok[dest] = tok; row_w[dest] = w_a; rowof[tok * 2 + k] = dest; }
        if (blk < 32) { const int e = blk; for (int r = pstart[e] + cnt[e] + F.tid; r < pstart[e + 1]; r += NWAVES * 64) { row_tok[r] = 0; row_w[r] = 0.f; } }
        if (blk == 0) { const int np = pstart[32] >> 8; if (F.tid == 0) pinfo[0] = np;
            for (int p = F.tid; p < np; p += NWAVES * 64) { int e = 0; for (int j = 1; j < 32; ++j) if (pstart[j] <= p * 256) e = j; pinfo[16 + p] = e; } }
        __syncthreads();
    }
}
__device__ __forceinline__ void load_pexp(Frame& F) {
    const int* pinfo = (const int*)(F.ws + SM_PINFO); LAS int* px = (LAS int*)(F.lds + PEXP_OFF);
    for (int i = F.tid; i < 16 + 288; i += NWAVES * 64) px[i] = __hip_atomic_load(pinfo + i, RLX_AGENT);
    __syncthreads();
}

__device__ __forceinline__ void p11_final(Frame& F, const Params& P) {
    const bf16* H = (const bf16*)(F.ws + WS_VH); const bf16* Y = (const bf16*)(F.ws + WS_Y); const int* rowof = (const int*)(F.ws + SM_ROWOF);
    const float* g2 = P.in[19]; const float* b2 = P.in[20]; float* out = P.out;
    const int gw = F.vcu * NWAVES + F.wave, NGW = F.G * NWAVES, l = F.lane;
    f32x4 gg[4], bb[4];
#pragma unroll
    for (int j = 0; j < 2; ++j) { gg[2 * j] = *(const GAS f32x4*)(g2 + 512 * j + 8 * l); gg[2 * j + 1] = *(const GAS f32x4*)(g2 + 512 * j + 8 * l + 4);
        bb[2 * j] = *(const GAS f32x4*)(b2 + 512 * j + 8 * l); bb[2 * j + 1] = *(const GAS f32x4*)(b2 + 512 * j + 8 * l + 4); }
    for (int row = gw; row < M; row += NGW) {
        const int r1 = rowof[row * 2], r2 = rowof[row * 2 + 1];
        float z[16];
#pragma unroll
        for (int j = 0; j < 2; ++j) { const v4u hw = *(const GAS v4u*)(H + (size_t)row * D + 512 * j + 8 * l), y1 = *(const GAS v4u*)(Y + (size_t)r1 * D + 512 * j + 8 * l), y2 = *(const GAS v4u*)(Y + (size_t)r2 * D + 512 * j + 8 * l);
            float hf[8], a[8], b[8]; unpack8f(hw, hf); unpack8f(y1, a); unpack8f(y2, b);
#pragma unroll
            for (int e = 0; e < 8; ++e) z[8 * j + e] = ALPHA * hf[e] + (a[e] + b[e]); }
        float s = 0.f;
#pragma unroll
        for (int e = 0; e < 16; ++e) s += z[e];
        const float mean = wave_sum(s) * (1.0f / 1024.0f); float s2 = 0.f;
#pragma unroll
        for (int e = 0; e < 16; ++e) { z[e] -= mean; s2 += z[e] * z[e]; }
        const float rstd = 1.0f / sqrtf(wave_sum(s2) * (1.0f / 1024.0f) + EPS);
#pragma unroll
        for (int j = 0; j < 2; ++j) { f32x4 o0, o1;
#pragma unroll
            for (int e = 0; e < 4; ++e) { o0[e] = z[8 * j + e] * rstd * gg[2 * j][e] + bb[2 * j][e]; o1[e] = z[8 * j + 4 + e] * rstd * gg[2 * j + 1][e] + bb[2 * j + 1][e]; }
            *(GAS f32x4*)(out + (size_t)row * D + 512 * j + 8 * l) = o0; *(GAS f32x4*)(out + (size_t)row * D + 512 * j + 8 * l + 4) = o1; }
    }
}

__device__ __forceinline__ void attn_phase(Frame& F) {
    const bf16* Q = (const bf16*)(F.outb + OUT_Q); const bf16* K = (const bf16*)(F.ws + WS_K); const bf16* V = (const bf16*)(F.ws + WS_V); bf16* O = (bf16*)(F.ws + WS_O);
    for (int v = F.vcu; v < 256; v += F.G) {
        const int s = v & 7, bh = v >> 3;
#pragma unroll 1
        for (int i = 0; i < 4; ++i) { const int qb = (i == 0) ? s : (i == 1) ? 15 - s : (i == 2) ? 16 + s : 31 - s;
            attn::attn_unit<8>(bh >> 3, bh & 7, qb, Q, K, V, O, F.lds + RING_OFF); }
    }
    __syncthreads();
}

constexpr int N_PHASES = 12;
__global__ void __launch_bounds__(NWAVES * 64, 2) mk_fwd(Params P) {
    extern __shared__ __attribute__((aligned(16))) unsigned char lds_raw[];
    Frame F;
    F.lds = (LAS unsigned char*)lds_raw;
    F.MISC = (volatile LAS unsigned*)(F.lds + MISC_OFF);
    frame_ids(F);
    F.G = gridDim.x; { const int bx = blockIdx.x; F.vcu = (F.G % 8 == 0) ? (bx % 8) * (F.G / 8) + bx / 8 : bx; }
    F.ws = P.ws; F.outb = (unsigned char*)P.out;
    unsigned char* ws = P.ws;
    for (int u = F.tid; u < (LDS_BYTES - LDSCTL_OFF) / 4; u += NWAVES * 64) ((LAS unsigned*)(F.lds + LDSCTL_OFF))[u] = 0u;
    __syncthreads();
    XcdBarrier bar; bar.bar = (unsigned*)(ws + WS_CTL) + CW_BAR; bar.x = 0; bar.st = nullptr;
    if (MK_N_LAUNCHES == 1) bar = xcd_barrier_post((unsigned*)(ws + WS_CTL) + CW_BAR, F.MISC + 8);
    const int lo = P.ph_lo, hi = P.ph_hi;
#define IN(k) (lo <= (k) && (k) < hi)
#define SEAM(k) do { if (IN(k) && IN((k) + 1)) xcd_barrier(bar); } while (0)
    typedef pg8::StaticOrder SO;

    if (IN(0)) { frame_ids(F); p0_prologue(F, P); } SEAM(0);

    if (IN(1)) {
        pg8::OpsPlain G{(const char*)(ws + WS_XB), (const char*)(ws + W_IN_T), 1024, 1024, 0}; SO S; S.init(M / 256, PBW / 256, F.G, (int)blockIdx.x);
        pg8::EpiProj E{(bf16*)(ws + WS_PB)};
        pg8::gemm_phase<pg8::EpiProj, SO, pg8::OpsPlain, true>(F.lds + RING_OFF, G, S, E);
    } SEAM(1);

    if (IN(2)) { frame_ids(F); p2_thin(F); } SEAM(2);

    if (IN(3)) {
        {
          pg8::OpsPlain G{(const char*)(ws + WS_POOLED), (const char*)(ws + W_POOL_T), 128, 512, 256}; SO S; S.init(M / 256, 4, F.G, (int)blockIdx.x);
          pg8::EpiPool E{(bf16*)(F.outb + OUT_TP), (const bf16*)(ws + WS_PB), P.in[3]};
          pg8::gemm_phase<pg8::EpiPool, SO, pg8::OpsPlain, true>(F.lds + RING_OFF, G, S, E); }
        __syncthreads();
        {
          pg8::OpsPlain G{(const char*)(ws + WS_PB) + C_CQ * 2, (const char*)(ws + W_UQ_T), 384, PBW, 0}; SO S; S.init(M / 256, 3, F.G, (int)blockIdx.x);
          pg8::EpiQ E{(bf16*)(F.outb + OUT_Q), (const float*)(ws + SM_RQ), (const float*)(ws + SM_ROPE)};
          pg8::gemm_phase<pg8::EpiQ, SO, pg8::OpsPlain, true>(F.lds + RING_OFF, G, S, E); }
        __syncthreads();
        {
          pg8::OpsPlain G{(const char*)(ws + WS_PB) + C_CKV * 2, (const char*)(ws + W_UKV_T), 256, PBW, 0}; SO S; S.init(M / 256, 4, F.G, (int)blockIdx.x);
          pg8::EpiKV E{(bf16*)(ws + WS_K), (bf16*)(ws + WS_V), (const float*)(ws + SM_RKV)};
          pg8::gemm_phase<pg8::EpiKV, SO, pg8::OpsPlain, true>(F.lds + RING_OFF, G, S, E); }
    } SEAM(3);

    if (IN(4)) { frame_ids(F); attn_phase(F); } SEAM(4);

    if (IN(5)) {
        pg8::OpsPlain G{(const char*)(ws + WS_O), (const char*)(ws + W_MLAO_T), 512, 512, 0}; SO S; S.init(M / 256, 4, F.G, (int)blockIdx.x);
        pg8::EpiMla E{(bf16*)(F.outb + OUT_TP), (const bf16*)(ws + WS_PB)};
        pg8::gemm_phase<pg8::EpiMla, SO, pg8::OpsPlain, true>(F.lds + RING_OFF, G, S, E);
    } SEAM(5);

    if (IN(6)) {
        pg8::OpsPlain G{(const char*)(F.outb + OUT_TP), (const char*)(ws + W_OUT_T), 1024, 1024, 0}; SO S; S.init(M / 256, 4, F.G, (int)blockIdx.x);
        pg8::EpiOut E{(bf16*)(ws + WS_VH), P.in[0], (float*)(ws + SM_STATS)};
        pg8::gemm_phase<pg8::EpiOut, SO, pg8::OpsPlain, true>(F.lds + RING_OFF, G, S, E);
    } SEAM(6);

    if (IN(7)) { frame_ids(F); p7_ln_router(F, P); } SEAM(7);
    if (IN(8)) { frame_ids(F); p8_scatter(F); } SEAM(8);

    if (IN(9)) {
        frame_ids(F); load_pexp(F); const LAS int* px = (const LAS int*)(F.lds + PEXP_OFF); const int np = px[0];
        pg8::OpsMoe1 G{(const char*)(ws + WS_VH), (const char*)(ws + W_GU_T), 1024, 1024, (const int*)(ws + SM_ROWTOK), px}; SO S; S.init(np, 4, F.G, (int)blockIdx.x);
        pg8::EpiHid E{(bf16*)(ws + WS_HID)};
        pg8::gemm_phase<pg8::EpiHid, SO, pg8::OpsMoe1, true>(F.lds + RING_OFF, G, S, E);
    } SEAM(9);

    if (IN(10)) {
        frame_ids(F); load_pexp(F); const LAS int* px = (const LAS int*)(F.lds + PEXP_OFF); const int np = px[0];
        pg8::OpsMoe2 G{(const char*)(ws + WS_HID), (const char*)(ws + W_DN_T), 512, 512, px}; SO S; S.init(np, 4, F.G, (int)blockIdx.x);
        pg8::EpiDown E{(bf16*)(ws + WS_Y), (const float*)(ws + SM_ROWW)};
        pg8::gemm_phase<pg8::EpiDown, SO, pg8::OpsMoe2, true>(F.lds + RING_OFF, G, S, E);
    } SEAM(10);

    if (IN(11)) { frame_ids(F); p11_final(F, P); }
#undef IN
#undef SEAM
}

extern "C" void kernel_launch(void* const* d_in, const int* in_sizes, int n_in, void* d_out, int out_size, void* d_ws, size_t ws_size, hipStream_t stream) {
    static int grid = 0;
    if (grid == 0) {
        if (n_in != 21 || out_size != M * D || ws_size < WS_END) { fprintf(stderr, "kernel_launch: unexpected shapes: n_in %d out %d ws %zu\n", n_in, out_size, ws_size); grid = -1; return; }
        int dev = 0, cus = 0, per_cu = 0;
        if (hipGetDevice(&dev) != hipSuccess || hipDeviceGetAttribute(&cus, hipDeviceAttributeMultiprocessorCount, dev) != hipSuccess) { grid = -1; return; }
        if (hipFuncSetAttribute((const void*)mk_fwd, hipFuncAttributeMaxDynamicSharedMemorySize, LDS_BYTES) != hipSuccess) { fprintf(stderr, "kernel_launch: hipFuncSetAttribute failed\n"); grid = -1; return; }
        if (hipOccupancyMaxActiveBlocksPerMultiprocessor(&per_cu, (const void*)mk_fwd, NWAVES * 64, LDS_BYTES) != hipSuccess || per_cu < 1) { fprintf(stderr, "kernel_launch: occupancy query says %d\n", per_cu); }
        (void)hipGetLastError();
        grid = cus < 256 ? cus : 256;
    }
    if (grid < 0) return;
    (void)hipMemsetAsync((char*)d_ws + WS_CTL, 0, CTL_ZERO_BYTES, stream);
    Params p{};
    for (int i = 0; i < 21; ++i) p.in[i] = (const float*)d_in[i];
    p.out = (float*)d_out; p.ws = (unsigned char*)d_ws;
#if MK_N_LAUNCHES == 1
    p.ph_lo = 0; p.ph_hi = N_PHASES;
    hipLaunchKernelGGL(mk_fwd, dim3(grid), dim3(NWAVES * 64), LDS_BYTES, stream, p);
#else
    for (int k = 0; k < N_PHASES; ++k) { p.ph_lo = k; p.ph_hi = k + 1; hipLaunchKernelGGL(mk_fwd, dim3(grid), dim3(NWAVES * 64), LDS_BYTES, stream, p); }
#endif
}
```

```cpp
#include <hip/hip_runtime.h>
#include <cstdio>
#include <cstdint>

#ifndef PROBE_REPEAT_MASK
#define PROBE_REPEAT_MASK 0
#endif
#ifndef MK_N_LAUNCHES
#define MK_N_LAUNCHES 1
#endif

#define GAS __attribute__((address_space(1)))
#define LAS __attribute__((address_space(3)))
typedef unsigned short bf16;
typedef unsigned v4u __attribute__((ext_vector_type(4)));
typedef unsigned v2u __attribute__((ext_vector_type(2)));
typedef float f32x4 __attribute__((ext_vector_type(4)));
typedef float f32x2 __attribute__((ext_vector_type(2)));
typedef float f32x16 __attribute__((ext_vector_type(16)));
typedef short bf16x8 __attribute__((ext_vector_type(8)));
typedef short s16x4 __attribute__((ext_vector_type(4)));

constexpr int BATCH = 4, SEQ = 8192, D = 1024, M = BATCH * SEQ;
constexpr int NH = 8, QKD = 96, VD = 64;
constexpr int PBW = 3328;
constexpr int C_U = 0, C_CQ = 512, C_CKV = 896, C_KPE = 1152, C_G0 = 1280, C_G1 = 2304;
constexpr int QP = NH * QKD;
constexpr int NEXP = 32, DEXP = 512;
constexpr int RMAX = 73728;
constexpr float EPS = 1e-5f;
constexpr float ALPHA = 1.189207115002721f;
constexpr float LOG2E = 1.4426950408889634f;
constexpr float QSCALE = 0.10206207261596575f * 1.4426950408889634f;

constexpr size_t MiB = 1u << 20, KiB = 1024;
constexpr size_t WS_CTL = 0, CTL_ZERO_BYTES = 1 * MiB;
constexpr size_t WS_SMALL = 1 * MiB;
constexpr size_t SM_RQ = WS_SMALL, SM_RKV = WS_SMALL + 128 * KiB, SM_RECS = WS_SMALL + 256 * KiB, SM_ROWTOK = WS_SMALL + 768 * KiB, SM_ROWW = WS_SMALL + 1088 * KiB,
                 SM_ROWOF = WS_SMALL + 1408 * KiB, SM_BLKCNT = WS_SMALL + 1664 * KiB, SM_PINFO = WS_SMALL + 1696 * KiB, SM_ROPE = WS_SMALL + 1792 * KiB, SM_STATS = WS_SMALL + 3072 * KiB;
constexpr size_t WS_W = 8 * MiB;
constexpr size_t W_IN_T = WS_W, W_POOL_T = WS_W + 7 * MiB, W_UQ_T = WS_W + 7 * MiB + 256 * KiB, W_UKV_T = WS_W + 8 * MiB, W_ROUTER_T = WS_W + 8 * MiB + 512 * KiB,
                 W_MLAO_T = WS_W + 9 * MiB, W_OUT_T = WS_W + 10 * MiB, W_GU_T = WS_W + 12 * MiB, W_DN_T = WS_W + 76 * MiB;
constexpr size_t WS_XB = 120 * MiB;
constexpr size_t WS_POOLED = WS_XB, WS_O = WS_XB + 32 * MiB, WS_H = WS_XB;
constexpr size_t WS_PB = 184 * MiB;
constexpr size_t WS_Y = WS_PB, WS_VH = WS_PB + 144 * MiB;
constexpr size_t WS_K = 392 * MiB, WS_V = 440 * MiB;
constexpr size_t WS_HID = WS_K;
constexpr size_t WS_END = 472 * MiB;
constexpr size_t OUT_TP = 0, OUT_Q = 64 * MiB;

constexpr int CW_TMO = 0, CW_BAR = 4096;

constexpr int RING_OFF = 0, RING_BYTES = 131072;
constexpr int LDSCTL_OFF = RING_BYTES, MISC_OFF = LDSCTL_OFF + 320, PEXP_OFF = LDSCTL_OFF + 512;
constexpr int LDS_BYTES = 147456;

#define RLX_AGENT __ATOMIC_RELAXED, __HIP_MEMORY_SCOPE_AGENT
#define LDS_WAIT() asm volatile("s_waitcnt lgkmcnt(0)" ::: "memory")
#define VM_WAIT() asm volatile("s_waitcnt vmcnt(0)" ::: "memory")
__device__ __forceinline__ unsigned f2bf(float f) { unsigned u = __builtin_bit_cast(unsigned, f); return (u + 0x7fffu + ((u >> 16) & 1u)) >> 16; }
__device__ __forceinline__ unsigned pk2(float lo, float hi) { return f2bf(lo) | (f2bf(hi) << 16); }
__device__ __forceinline__ float bflo(unsigned w) { return __uint_as_float(w << 16); }
__device__ __forceinline__ float bfhi(unsigned w) { return __uint_as_float(w & 0xffff0000u); }
__device__ __forceinline__ float fast_sigmoid(float x) { return __builtin_amdgcn_rcpf(1.0f + __builtin_amdgcn_exp2f(-x * LOG2E)); }
__device__ __forceinline__ int opaque_tid() { int t = (int)threadIdx.x; asm volatile("" : "+v"(t)); return t; }
__device__ __forceinline__ float wave_sum(float v) {
#pragma unroll
    for (int o = 1; o < 64; o <<= 1) v += __shfl_xor(v, o);
    return v;
}

namespace pg8 {
#define PG8_LAS __attribute__((address_space(3)))
typedef unsigned short bf16_t;
typedef unsigned u32x4 __attribute__((ext_vector_type(4)));
constexpr int BM = 256, BK = 64, HALF = 128, HTB = HALF * BK * 2, STAGE_BYTES = 8 * HTB, NXCD = 8, WGM = 8;

__host__ __device__ __forceinline__ int lds_byte(int r, int c) { const int st = (r >> 4) * 2 + (c >> 5), rr = r & 15, cc = c & 31, ob = rr * 64 + cc * 2; return st * 1024 + (ob ^ (((ob >> 9) & 1) << 5)); }
__host__ __device__ __forceinline__ void stage_rc(int b, int& R, int& C) { const int st = b / 1024, sb = b % 1024, swz = sb ^ (((sb >> 9) & 1) << 5); R = (st >> 1) * 16 + swz / 64; C = (st & 1) * 32 + (swz % 64) / 2; }
__host__ __device__ __forceinline__ int perm32(int rho) { const int n = rho >> 4, i = rho & 15; return 8 * (i >> 2) + 4 * n + (i & 3); }

struct Unit { int pm, pn; };

struct StaticOrder {
    int nM, nN, nwg, G, c;
    __host__ __device__ void init(int nM_, int nN_, int G_, int c_) { nM = nM_; nN = nN_; nwg = nM * nN; G = G_; c = c_; }
    __host__ __device__ bool next(int i, Unit& u) const {
        const long L = (long)i * G + c; if (L >= nwg) return false;
        int wgid = (int)L; { const int q = nwg / NXCD, r = nwg % NXCD, xcd = wgid % NXCD, off = wgid / NXCD; wgid = (xcd < r ? xcd * (q + 1) : r * (q + 1) + (xcd - r) * q) + off; }
        const int nig = WGM * nN, gid = wgid / nig, fm = gid * WGM, gsz = (nM - fm) < WGM ? (nM - fm) : WGM;
        u.pm = fm + ((wgid % nig) % gsz); u.pn = (wgid % nig) / gsz; return true;
    }
};

__device__ __forceinline__ unsigned cvt_pk_bf16(float lo, float hi) { unsigned r; asm volatile("v_cvt_pk_bf16_f32 %0, %1, %2" : "=v"(r) : "v"(lo), "v"(hi)); return r; }

struct OpsPlain {
    static constexpr bool GATHER = false;
    const char* A; const char* Bt; int K, lda; size_t a_pn;
    __device__ __forceinline__ const char* a_base(const Unit& u) const { return A + (size_t)u.pm * ((size_t)BM * lda * 2) + (size_t)u.pn * a_pn; }
    __device__ __forceinline__ const char* b_base(const Unit& u) const { return Bt + (size_t)u.pn * ((size_t)BM * K * 2); }
    __device__ __forceinline__ void a_off(const Unit&, const int (&R)[2], const int (&C)[2], unsigned (&o0)[2], unsigned (&o1)[2]) const {
#pragma unroll
        for (int i = 0; i < 2; ++i) { o0[i] = (unsigned)(R[i] * lda + C[i]) * 2u; o1[i] = o0[i]; } }
};
struct OpsMoe1 {
    static constexpr bool GATHER = true;
    const char* A; const char* Bt; int K, lda; const int* row_tok; const PG8_LAS int* pexp;
    __device__ __forceinline__ const char* a_base(const Unit&) const { return A; }
    __device__ __forceinline__ const char* b_base(const Unit& u) const { const int e = pexp[16 + u.pm]; return Bt + ((size_t)e * 1024 + (size_t)u.pn * BM) * ((size_t)K * 2); }
    __device__ __forceinline__ void a_off(const Unit& u, const int (&R)[2], const int (&C)[2], unsigned (&o0)[2], unsigned (&o1)[2]) const {
#pragma unroll
        for (int i = 0; i < 2; ++i) { const int t0 = row_tok[u.pm * BM + R[i]], t1 = row_tok[u.pm * BM + HALF + R[i]];
            o0[i] = (unsigned)(t0 * lda + C[i]) * 2u; o1[i] = (unsigned)(t1 * lda + C[i]) * 2u; } }
};
struct OpsMoe2 {
    static constexpr bool GATHER = false;
    const char* A; const char* Bt; int K, lda; const PG8_LAS int* pexp;
    __device__ __forceinline__ const char* a_base(const Unit& u) const { return A + (size_t)u.pm * ((size_t)BM * lda * 2); }
    __device__ __forceinline__ const char* b_base(const Unit& u) const { const int e = pexp[16 + u.pm]; return Bt + ((size_t)e * 1024 + (size_t)u.pn * BM) * ((size_t)K * 2); }
    __device__ __forceinline__ void a_off(const Unit&, const int (&R)[2], const int (&C)[2], unsigned (&o0)[2], unsigned (&o1)[2]) const {
#pragma unroll
        for (int i = 0; i < 2; ++i) { o0[i] = (unsigned)(R[i] * lda + C[i]) * 2u; o1[i] = o0[i]; } }
};

#define EPI_LOOP_AI_M for (int ai = 0; ai < 2; ++ai) _Pragma("unroll") for (int m = 0; m < 4; ++m)
__device__ __forceinline__ u32x4 pack8(const f32x4& v0, const f32x4& v1) { u32x4 w; w.x = cvt_pk_bf16(v0[0], v0[1]); w.y = cvt_pk_bf16(v0[2], v0[3]); w.z = cvt_pk_bf16(v1[0], v1[1]); w.w = cvt_pk_bf16(v1[2], v1[3]); return w; }
__device__ __forceinline__ void unpack8(const u32x4& w, f32x4& v0, f32x4& v1) { v0 = (f32x4){bflo(w.x), bfhi(w.x), bflo(w.y), bfhi(w.y)}; v1 = (f32x4){bflo(w.z), bfhi(w.z), bflo(w.w), bfhi(w.w)}; }

struct EpiProj {
    bf16_t* PB;
    __device__ __forceinline__ void operator()(const f32x4 (&acc)[2][2][4][2], const Unit& u, int wr, int wc, int fr, int fq) const {
        const int row0 = u.pm * BM + wr * 64 + fr, col0 = u.pn * BM + wc * 32 + 8 * fq; const bool sig = u.pn >= 5;
#pragma unroll
        EPI_LOOP_AI_M { bf16_t* rowp = PB + (size_t)(row0 + ai * HALF + m * 16) * PBW + col0;
#pragma unroll
            for (int bj = 0; bj < 2; ++bj) { f32x4 v0 = acc[ai][bj][m][0], v1 = acc[ai][bj][m][1];
                if (sig) {
#pragma unroll
                    for (int j = 0; j < 4; ++j) { v0[j] = fast_sigmoid(v0[j]); v1[j] = fast_sigmoid(v1[j]); } }
                *(u32x4*)(rowp + bj * HALF) = pack8(v0, v1); } }
    }
};
struct EpiPool {
    bf16_t* TP; const bf16_t* PB; const float* pscale;
    __device__ __forceinline__ void operator()(const f32x4 (&acc)[2][2][4][2], const Unit& u, int wr, int wc, int fr, int fq) const {
        const int row0 = u.pm * BM + wr * 64 + fr, col0 = u.pn * BM + wc * 32 + 8 * fq;
        f32x4 ps[2][2];
#pragma unroll
        for (int bj = 0; bj < 2; ++bj)
#pragma unroll
            for (int n = 0; n < 2; ++n) ps[bj][n] = *(const f32x4*)(pscale + col0 + bj * HALF + 4 * n);
#pragma unroll
        EPI_LOOP_AI_M { const size_t row = (size_t)(row0 + ai * HALF + m * 16);
#pragma unroll
            for (int bj = 0; bj < 2; ++bj) { const u32x4 gw = *(const u32x4*)(PB + row * PBW + C_G0 + col0 + bj * HALF); f32x4 g0, g1; unpack8(gw, g0, g1);
                const f32x4 v0 = acc[ai][bj][m][0] * ps[bj][0] * g0, v1 = acc[ai][bj][m][1] * ps[bj][1] * g1;
                *(u32x4*)(TP + row * D + col0 + bj * HALF) = pack8(v0, v1); } }
    }
};
struct EpiQ {
    bf16_t* Q; const float* rq; const float* rope;
    __device__ __forceinline__ void operator()(const f32x4 (&acc)[2][2][4][2], const Unit& u, int wr, int wc, int fr, int fq) const {
        const int row0 = u.pm * BM + wr * 64 + fr;
#pragma unroll
        EPI_LOOP_AI_M { const int row = row0 + ai * HALF + m * 16; const float sc = rq[row] * QSCALE; const int pos = row & (SEQ - 1);
#pragma unroll
            for (int bj = 0; bj < 2; ++bj) { f32x4 v0 = acc[ai][bj][m][0] * sc, v1 = acc[ai][bj][m][1] * sc; const int cc = bj * HALF + wc * 32 + 8 * fq;
                if (u.pn < 2) { const int col = u.pn * BM + cc, h = col >> 6, d = col & 63;
                    *(u32x4*)(Q + (size_t)row * QP + h * QKD + d) = pack8(v0, v1); }
                else { const int h = cc >> 5, i2 = cc & 31; const float* rt = rope + ((size_t)pos * 16 + (i2 >> 1)) * 2;
                    const f32x4 c0 = *(const f32x4*)rt, c1 = *(const f32x4*)(rt + 4);
                    const f32x4 o0 = (f32x4){v0[0] * c0[0] - v0[1] * c0[1], v0[0] * c0[1] + v0[1] * c0[0], v0[2] * c0[2] - v0[3] * c0[3], v0[2] * c0[3] + v0[3] * c0[2]};
                    const f32x4 o1 = (f32x4){v1[0] * c1[0] - v1[1] * c1[1], v1[0] * c1[1] + v1[1] * c1[0], v1[2] * c1[2] - v1[3] * c1[3], v1[2] * c1[3] + v1[3] * c1[2]};
                    *(u32x4*)(Q + (size_t)row * QP + h * QKD + 64 + i2) = pack8(o0, o1); } } }
    }
};
struct EpiKV {
    bf16_t* Kf; bf16_t* V; const float* rkv;
    __device__ __forceinline__ void operator()(const f32x4 (&acc)[2][2][4][2], const Unit& u, int wr, int wc, int fr, int fq) const {
        const int row0 = u.pm * BM + wr * 64 + fr;
#pragma unroll
        EPI_LOOP_AI_M { const int row = row0 + ai * HALF + m * 16; const float sc = rkv[row];
#pragma unroll
            for (int bj = 0; bj < 2; ++bj) { const f32x4 v0 = acc[ai][bj][m][0] * sc, v1 = acc[ai][bj][m][1] * sc; const int col = (u.pn & 1) * BM + bj * HALF + wc * 32 + 8 * fq;
                if (u.pn < 2) { const int h = col >> 6, d = col & 63; *(u32x4*)(Kf + (size_t)row * QP + h * QKD + d) = pack8(v0, v1); }
                else *(u32x4*)(V + (size_t)row * 512 + col) = pack8(v0, v1); } }
    }
};
struct EpiMla {
    bf16_t* TP; const bf16_t* PB;
    __device__ __forceinline__ void operator()(const f32x4 (&acc)[2][2][4][2], const Unit& u, int wr, int wc, int fr, int fq) const {
        const int row0 = u.pm * BM + wr * 64 + fr, col0 = u.pn * BM + wc * 32 + 8 * fq;
#pragma unroll
        EPI_LOOP_AI_M { const size_t row = (size_t)(row0 + ai * HALF + m * 16);
#pragma unroll
            for (int bj = 0; bj < 2; ++bj) { const u32x4 gw = *(const u32x4*)(PB + row * PBW + C_G1 + col0 + bj * HALF); const u32x4 tw = *(const u32x4*)(TP + row * D + col0 + bj * HALF);
                f32x4 g0, g1, t0, t1; unpack8(gw, g0, g1); unpack8(tw, t0, t1);
                const f32x4 v0 = t0 + acc[ai][bj][m][0] * g0, v1 = t1 + acc[ai][bj][m][1] * g1;
                *(u32x4*)(TP + row * D + col0 + bj * HALF) = pack8(v0, v1); } }
    }
};
struct EpiOut {
    bf16_t* VH; const float* x; float* stats;
    __device__ __forceinline__ void operator()(const f32x4 (&acc)[2][2][4][2], const Unit& u, int wr, int wc, int fr, int fq) const {
        const int row0 = u.pm * BM + wr * 64 + fr, col0 = u.pn * BM + wc * 32 + 8 * fq;
#pragma unroll
        EPI_LOOP_AI_M { const size_t row = (size_t)(row0 + ai * HALF + m * 16); float s = 0.f, q = 0.f;
#pragma unroll
            for (int bj = 0; bj < 2; ++bj) { const float* xp = x + row * D + col0 + bj * HALF; const f32x4 x0 = *(const f32x4*)xp, x1 = *(const f32x4*)(xp + 4);
                const f32x4 v0 = x0 * ALPHA + acc[ai][bj][m][0], v1 = x1 * ALPHA + acc[ai][bj][m][1];
                s += (v0[0] + v0[1]) + (v0[2] + v0[3]) + (v1[0] + v1[1]) + (v1[2] + v1[3]);
                q += (v0[0] * v0[0] + v0[1] * v0[1]) + (v0[2] * v0[2] + v0[3] * v0[3]) + (v1[0] * v1[0] + v1[1] * v1[1]) + (v1[2] * v1[2] + v1[3] * v1[3]);
                *(u32x4*)(VH + row * D + col0 + bj * HALF) = pack8(v0, v1); }
            s += __shfl_xor(s, 16); s += __shfl_xor(s, 32); q += __shfl_xor(q, 16); q += __shfl_xor(q, 32);
            if (fq == 0) *(f32x2*)(stats + row * 32 + (u.pn * 4 + wc) * 2) = (f32x2){s, q}; }
    }
};
struct EpiHid {
    bf16_t* HID;
    __device__ __forceinline__ void operator()(const f32x4 (&acc)[2][2][4][2], const Unit& u, int wr, int wc, int fr, int fq) const {
        const int row0 = u.pm * BM + wr * 64 + fr, col0 = u.pn * HALF + wc * 32 + 8 * fq;
#pragma unroll
        EPI_LOOP_AI_M { const size_t row = (size_t)(row0 + ai * HALF + m * 16); f32x4 v0, v1;
#pragma unroll
            for (int j = 0; j < 4; ++j) { const float g0 = acc[ai][0][m][0][j], g1 = acc[ai][0][m][1][j];
                v0[j] = g0 * fast_sigmoid(g0) * acc[ai][1][m][0][j]; v1[j] = g1 * fast_sigmoid(g1) * acc[ai][1][m][1][j]; }
            *(u32x4*)(HID + row * DEXP + col0) = pack8(v0, v1); }
    }
};
struct EpiDown {
    bf16_t* Y; const float* roww;
    __device__ __forceinline__ void operator()(const f32x4 (&acc)[2][2][4][2], const Unit& u, int wr, int wc, int fr, int fq) const {
        const int row0 = u.pm * BM + wr * 64 + fr, col0 = u.pn * BM + wc * 32 + 8 * fq;
#pragma unroll
        EPI_LOOP_AI_M { const size_t row = (size_t)(row0 + ai * HALF + m * 16); const float w = roww[row];
#pragma unroll
            for (int bj = 0; bj < 2; ++bj) *(u32x4*)(Y + row * D + col0 + bj * HALF) = pack8(acc[ai][bj][m][0] * w, acc[ai][bj][m][1] * w); }
    }
};

template <class Epi, class Sched, class Ops, bool ALIGN_EPI>
__device__ __forceinline__ void gemm_phase(PG8_LAS unsigned char* lds, const Ops& G, const Sched& S, const Epi& E) {
    const int tid = opaque_tid(), wid = __builtin_amdgcn_readfirstlane(tid >> 6), lane = tid & 63, wr = wid >> 2, wc = wid & 3, fr = lane & 15, fq = lane >> 4;
    const int K = G.K, nt = K / BK;
    unsigned voffB[2]; int Rr[2], Cc[2];
#pragma unroll
    for (int i = 0; i < 2; ++i) { int R, C; stage_rc(tid * 16 + i * 8192, R, C); const int Rb = (R & ~31) + perm32(R & 31); Rr[i] = R; Cc[i] = C; voffB[i] = (unsigned)(Rb * K + C) * 2u; }
    const size_t kstep = (size_t)(BK * 2);
    const size_t hstepB = (size_t)HALF * K * 2;
    const unsigned ldsw = (unsigned)wid * 1024u;
    const int aoff = lds_byte(wr * 64 + fr, fq * 8), boff = lds_byte(wc * 32 + fr, fq * 8);
#define PG8_SA(b, h) (((b) * 2 + (h)) * HTB)
#define PG8_SB(b, h) ((4 + (b) * 2 + (h)) * HTB)
#define PG8_STAGE(bufoff, gbase, voff) do { _Pragma("unroll") for (int _i = 0; _i < 2; ++_i) \
        __builtin_amdgcn_global_load_lds((const unsigned*)((const char*)(gbase) + (voff)[_i]), (PG8_LAS unsigned*)(lds + (bufoff) + ldsw + _i * 8192), 16, 0, 0); } while (0)
#define PG8_LDA(dst, b, h) do { _Pragma("unroll") for (int m = 0; m < 4; ++m) _Pragma("unroll") for (int k = 0; k < 2; ++k) dst[m][k] = *(const PG8_LAS bf16x8*)(lds + PG8_SA(b, h) + aoff + m * 2048 + k * 1024); } while (0)
#define PG8_LDB(dst, b, h) do { _Pragma("unroll") for (int n = 0; n < 2; ++n) _Pragma("unroll") for (int k = 0; k < 2; ++k) dst[n][k] = *(const PG8_LAS bf16x8*)(lds + PG8_SB(b, h) + boff + n * 2048 + k * 1024); } while (0)
#define PG8_MMA(ai, bj, At, Bt) do { __builtin_amdgcn_s_setprio(1); _Pragma("unroll") for (int m = 0; m < 4; ++m) _Pragma("unroll") for (int n = 0; n < 2; ++n) _Pragma("unroll") for (int k = 0; k < 2; ++k) \
        acc[ai][bj][m][n] = __builtin_amdgcn_mfma_f32_16x16x32_bf16(Bt[n][k], At[m][k], acc[ai][bj][m][n], 0, 0, 0); __builtin_amdgcn_s_setprio(0); } while (0)
#define PG8_WAIT_V(n) asm volatile("s_waitcnt vmcnt(" #n ")" ::: "memory")
#define PG8_WAIT_L(n) asm volatile("s_waitcnt lgkmcnt(" #n ")" ::: "memory")
#define PG8_BAR __builtin_amdgcn_s_barrier()
#define PG8_SCHED __builtin_amdgcn_sched_barrier(0)
    Unit cur, nxt; int ui = 0;
    if (!S.next(0, cur)) return;
    f32x4 acc[2][2][4][2];
#pragma unroll
    for (int a = 0; a < 2; ++a)
#pragma unroll
        for (int b = 0; b < 2; ++b)
#pragma unroll
            for (int m = 0; m < 4; ++m)
#pragma unroll
                for (int n = 0; n < 2; ++n) acc[a][b][m][n] = (f32x4){0.f, 0.f, 0.f, 0.f};
    bf16x8 At[4][2], B0[2][2], B1[2][2];
    unsigned cA0[2], cA1[2], nA0[2], nA1[2];
    G.a_off(cur, Rr, Cc, cA0, cA1);
#pragma unroll
    for (int i = 0; i < 2; ++i) { nA0[i] = cA0[i]; nA1[i] = cA1[i]; }
    const size_t hstepA = Ops::GATHER ? 0 : (size_t)HALF * G.lda * 2;
#define PG8_A1(cur_) (Ops::GATHER ? (cur_##1) : (cur_##0))
    const char* cA = G.a_base(cur); const char* cB = G.b_base(cur);
    PG8_STAGE(PG8_SB(0, 0), cB, voffB); PG8_STAGE(PG8_SB(0, 1), cB + hstepB, voffB); PG8_STAGE(PG8_SA(0, 0), cA, cA0); PG8_STAGE(PG8_SA(0, 1), cA + hstepA, PG8_A1(cA));
    if (wr == 1) PG8_BAR;
    PG8_WAIT_V(2); PG8_BAR;
    PG8_STAGE(PG8_SB(1, 0), cB + kstep, voffB); PG8_STAGE(PG8_SA(1, 0), cA + kstep, cA0); PG8_STAGE(PG8_SB(1, 1), cB + hstepB + kstep, voffB);
    PG8_WAIT_V(6); PG8_BAR;
    for (;;) {
        const bool has_next = S.next(ui + 1, nxt);
        const char* nA = has_next ? G.a_base(nxt) : cA; const char* nB = has_next ? G.b_base(nxt) : cB;
        for (int t = 0; t < nt; t += 2) {
            const bool last = (t == nt - 2);
            const char* a1 = cA + (size_t)(t + 1) * kstep;
            const char* a2 = last ? nA : cA + (size_t)(t + 2) * kstep; const char* b2 = last ? nB : cB + (size_t)(t + 2) * kstep;
            const char* a3 = a2 + kstep; const char* b3 = b2 + kstep;
            unsigned xA0[2], xA1[2];
            if constexpr (Ops::GATHER) { if (last && has_next) G.a_off(nxt, Rr, Cc, nA0, nA1);
#pragma unroll
                for (int i = 0; i < 2; ++i) { xA0[i] = last ? nA0[i] : cA0[i]; xA1[i] = last ? nA1[i] : cA1[i]; } }
            else {
#pragma unroll
                for (int i = 0; i < 2; ++i) { xA0[i] = cA0[i]; xA1[i] = cA0[i]; } }
            PG8_LDB(B0, 0, 0); PG8_LDB(B1, 0, 1); PG8_SCHED; PG8_LDA(At, 0, 0); PG8_STAGE(PG8_SA(1, 1), a1 + hstepA, PG8_A1(cA));
            PG8_WAIT_V(8); PG8_WAIT_L(0); PG8_BAR; PG8_MMA(0, 0, At, B0); PG8_MMA(0, 1, At, B1); PG8_BAR; PG8_SCHED;
            PG8_LDA(At, 0, 1); PG8_STAGE(PG8_SB(0, 0), b2, voffB); PG8_STAGE(PG8_SB(0, 1), b2 + hstepB, voffB); PG8_STAGE(PG8_SA(0, 0), a2, xA0);
            PG8_WAIT_V(8); PG8_WAIT_L(0); PG8_BAR; PG8_MMA(1, 0, At, B0); PG8_MMA(1, 1, At, B1); PG8_BAR; PG8_SCHED;
            PG8_LDB(B0, 1, 0); PG8_LDB(B1, 1, 1); PG8_SCHED; PG8_LDA(At, 1, 0); PG8_STAGE(PG8_SA(0, 1), a2 + hstepA, xA1);
            PG8_WAIT_V(8); PG8_WAIT_L(0); PG8_BAR; PG8_MMA(0, 0, At, B0); PG8_MMA(0, 1, At, B1); PG8_BAR; PG8_SCHED;
            PG8_LDA(At, 1, 1); PG8_STAGE(PG8_SB(1, 0), b3, voffB); PG8_STAGE(PG8_SB(1, 1), b3 + hstepB, voffB); PG8_STAGE(PG8_SA(1, 0), a3, xA0);
            PG8_WAIT_V(8); PG8_WAIT_L(0); PG8_BAR; PG8_MMA(1, 0, At, B0); PG8_MMA(1, 1, At, B1); PG8_BAR; PG8_SCHED;
        }
        if constexpr (ALIGN_EPI) { if (wr == 0) PG8_BAR; }
        E(acc, cur, wr, wc, fr, fq);
        if (!has_next) break;
#pragma unroll
        for (int a = 0; a < 2; ++a)
#pragma unroll
            for (int b = 0; b < 2; ++b)
#pragma unroll
                for (int m = 0; m < 4; ++m)
#pragma unroll
                    for (int n = 0; n < 2; ++n) acc[a][b][m][n] = (f32x4){0.f, 0.f, 0.f, 0.f};
        cur = nxt; cA = nA; cB = nB; ++ui;
#pragma unroll
        for (int i = 0; i < 2; ++i) { cA0[i] = nA0[i]; cA1[i] = nA1[i]; }
        if constexpr (ALIGN_EPI) { if (wr == 1) PG8_BAR; }
    }
    PG8_WAIT_V(0);
    if constexpr (!ALIGN_EPI) { if (wr == 0) PG8_BAR; }
    PG8_BAR;
#undef PG8_SA
#undef PG8_A1
#undef PG8_SB
#undef PG8_STAGE
#undef PG8_LDA
#undef PG8_LDB
#undef PG8_MMA
#undef PG8_WAIT_V
#undef PG8_WAIT_L
#undef PG8_BAR
#undef PG8_SCHED
}
}

namespace attn {
constexpr int KBUF = 12288, VBUF = 8192;
constexpr int LDS_K = 0, LDS_V = 2 * KBUF, LDS_WS = LDS_V + 2 * VBUF, LDS_OST = LDS_WS + 8 * 256, LDS_BYTES = LDS_OST + 8 * 4096;
typedef LAS const char* lds_cptr;
__device__ __forceinline__ int crow(int r, int hi) { return (r & 3) + 8 * (r >> 2) + 4 * hi; }
__device__ __forceinline__ float max3f(float a, float b, float c) { return __builtin_fmaxf(__builtin_fmaxf(a, b), c); }
__device__ __forceinline__ float rowmax(const f32x16& p0, const f32x16& p1) {
    float a = max3f(p0[0], p0[1], p1[0]), b = max3f(p0[2], p0[3], p1[1]); a = max3f(a, p1[2], p1[3]);
#pragma unroll
    for (int r = 4; r < 16; r += 4) { a = max3f(a, p0[r], p0[r + 1]); b = max3f(b, p0[r + 2], p0[r + 3]); a = max3f(a, p1[r], p1[r + 1]); b = max3f(b, p1[r + 2], p1[r + 3]); }
    const float m = __builtin_fmaxf(a, b);
    auto rr = __builtin_amdgcn_permlane32_swap(__float_as_uint(m), __float_as_uint(m), false, false);
    return __builtin_fmaxf(__uint_as_float(rr[0]), __uint_as_float(rr[1]));
}
__device__ __forceinline__ unsigned cvtpk(float lo, float hi) { unsigned r; asm volatile("v_cvt_pk_bf16_f32 %0, %1, %2" : "=v"(r) : "v"(lo), "v"(hi)); return r; }

template <int THRL> __device__ __forceinline__ void attn_unit(int b, int h, int qb, const bf16* Q, const bf16* __restrict__ K, const bf16* __restrict__ V, bf16* O, LAS unsigned char* shm) {
    const int tid = opaque_tid(), lane = tid & 63, r32 = lane & 31, hi = lane >> 5; const int wid = __builtin_amdgcn_readfirstlane(tid >> 6);
    const size_t rowbase = (size_t)b * SEQ; const int q0 = qb * 256;
    const bf16* Qw = Q + (rowbase + q0 + wid * 32) * QP + h * QKD;
    const bf16* Kh = K + rowbase * QP + h * QKD; const bf16* Vh = V + rowbase * 512 + h * VD;
    LAS float* wsf = (LAS float*)(shm + LDS_WS) + wid * 64;
    const int NT = 4 * qb + 4, my_nt = 4 * qb + (wid >> 1) + 1;
#define ATT_GLDS(src, dstoff) __builtin_amdgcn_global_load_lds((const unsigned*)(src), (LAS unsigned*)(shm + (dstoff)), 16, 0, 0)
#define ATT_DMA(t, buf) do { const bf16* ks_ = Kh + (size_t)((t) * 64 + lane) * QP; \
        ATT_GLDS(ks_ + wid * 8, LDS_K + (buf) * KBUF + wid * 1024); \
        if (wid < 4) ATT_GLDS(ks_ + (wid + 8) * 8, LDS_K + (buf) * KBUF + (wid + 8) * 1024); \
        ATT_GLDS(Vh + (size_t)((t) * 64 + 16 * (wid & 3) + (lane >> 2)) * 512 + (wid >> 2) * 32 + (lane & 3) * 8, LDS_V + (buf) * VBUF + wid * 1024); } while (0)
    ATT_DMA(0, 0);
    bf16x8 qr[6];
#pragma unroll
    for (int d0 = 0; d0 < 6; ++d0) qr[d0] = *reinterpret_cast<const bf16x8*>(&Qw[(size_t)r32 * QP + d0 * 16 + hi * 8]);
    float mrow = -1e30f, l_reg = 0.f; f32x16 o[2]; o[0] = f32x16{}; o[1] = f32x16{};
    const int vboff = ((lane >> 4) & 1) * 32 + (lane & 3) * 8 + (4 * hi + ((lane & 15) >> 2)) * 64;
    for (int t = 0; t < NT; ++t) {
        asm volatile("s_waitcnt vmcnt(0)" ::: "memory");
        __syncthreads();
        if (t + 1 < NT) ATT_DMA(t + 1, (t + 1) & 1);
        if (t < my_nt) {
            const int buf = t & 1;
            f32x16 p0 = f32x16{}, p1 = f32x16{};
            { lds_cptr kb = (lds_cptr)(shm + LDS_K + buf * KBUF) + hi * 1024 + r32 * 16;
              bf16x8 kf[12];
#pragma unroll
              for (int d0 = 0; d0 < 6; ++d0) { kf[2 * d0] = *(const LAS bf16x8*)(kb + d0 * 2048); kf[2 * d0 + 1] = *(const LAS bf16x8*)(kb + d0 * 2048 + 512); }
              __builtin_amdgcn_sched_barrier(0);
#pragma unroll
              for (int d0 = 0; d0 < 6; ++d0) { p0 = __builtin_amdgcn_mfma_f32_32x32x16_bf16(kf[2 * d0], qr[d0], p0, 0, 0, 0); p1 = __builtin_amdgcn_mfma_f32_32x32x16_bf16(kf[2 * d0 + 1], qr[d0], p1, 0, 0, 0); }
              __builtin_amdgcn_sched_barrier(0); }
            s16x4 vlo[8], vhh[8];
            { const int vb = (int)(uintptr_t)(shm + LDS_V + buf * VBUF) + vboff;
#pragma unroll
              for (int i = 0; i < 8; ++i) {
                  asm volatile("ds_read_b64_tr_b16 %0,%1 offset:%c2" : "=&v"(vlo[i]) : "v"(vb), "i"((i >> 2) * 4096 + (i & 3) * 1024) : "memory");
                  asm volatile("ds_read_b64_tr_b16 %0,%1 offset:%c2" : "=&v"(vhh[i]) : "v"(vb), "i"((i >> 2) * 4096 + (i & 3) * 1024 + 512) : "memory"); }
              __builtin_amdgcn_sched_barrier(0); }
            const float rm = rowmax(p0, p1);
            if (__any(rm > mrow + (float)THRL)) {
                const float mn = __builtin_fmaxf(mrow, rm); const float f = __builtin_amdgcn_exp2f(mrow - mn); l_reg *= f; mrow = mn;
                if (hi == 0) wsf[r32] = f;
                asm volatile("s_waitcnt lgkmcnt(0)" ::: "memory");
#pragma unroll
                for (int d_ = 0; d_ < 2; ++d_)
#pragma unroll
                    for (int r = 0; r < 16; ++r) o[d_][r] *= wsf[crow(r, hi)];
            }
            float sacc = 0.f;
#pragma unroll
            for (int r = 0; r < 16; ++r) { p0[r] = __builtin_amdgcn_exp2f(p0[r] - mrow); p1[r] = __builtin_amdgcn_exp2f(p1[r] - mrow); sacc += p0[r] + p1[r]; }
            l_reg += sacc;
            v4u pw0, pw1, pw2, pw3;
            pw0 = (v4u){cvtpk(p0[0], p0[1]), cvtpk(p0[2], p0[3]), cvtpk(p0[4], p0[5]), cvtpk(p0[6], p0[7])};
            pw1 = (v4u){cvtpk(p0[8], p0[9]), cvtpk(p0[10], p0[11]), cvtpk(p0[12], p0[13]), cvtpk(p0[14], p0[15])};
            pw2 = (v4u){cvtpk(p1[0], p1[1]), cvtpk(p1[2], p1[3]), cvtpk(p1[4], p1[5]), cvtpk(p1[6], p1[7])};
            pw3 = (v4u){cvtpk(p1[8], p1[9]), cvtpk(p1[10], p1[11]), cvtpk(p1[12], p1[13]), cvtpk(p1[14], p1[15])};
            asm volatile("s_waitcnt lgkmcnt(0)" ::: "memory"); __builtin_amdgcn_sched_barrier(0);
#define ATT_VF(i) (bf16x8){vlo[i][0], vlo[i][1], vlo[i][2], vlo[i][3], vhh[i][0], vhh[i][1], vhh[i][2], vhh[i][3]}
            o[0] = __builtin_amdgcn_mfma_f32_32x32x16_bf16(__builtin_bit_cast(bf16x8, pw0), ATT_VF(0), o[0], 0, 0, 0);
            o[1] = __builtin_amdgcn_mfma_f32_32x32x16_bf16(__builtin_bit_cast(bf16x8, pw0), ATT_VF(4), o[1], 0, 0, 0);
            o[0] = __builtin_amdgcn_mfma_f32_32x32x16_bf16(__builtin_bit_cast(bf16x8, pw1), ATT_VF(1), o[0], 0, 0, 0);
            o[1] = __builtin_amdgcn_mfma_f32_32x32x16_bf16(__builtin_bit_cast(bf16x8, pw1), ATT_VF(5), o[1], 0, 0, 0);
            o[0] = __builtin_amdgcn_mfma_f32_32x32x16_bf16(__builtin_bit_cast(bf16x8, pw2), ATT_VF(2), o[0], 0, 0, 0);
            o[1] = __builtin_amdgcn_mfma_f32_32x32x16_bf16(__builtin_bit_cast(bf16x8, pw2), ATT_VF(6), o[1], 0, 0, 0);
            o[0] = __builtin_amdgcn_mfma_f32_32x32x16_bf16(__builtin_bit_cast(bf16x8, pw3), ATT_VF(3), o[0], 0, 0, 0);
            o[1] = __builtin_amdgcn_mfma_f32_32x32x16_bf16(__builtin_bit_cast(bf16x8, pw3), ATT_VF(7), o[1], 0, 0, 0);
#undef ATT_VF
        }
    }
    { auto rr = __builtin_amdgcn_permlane32_swap(__float_as_uint(l_reg), __float_as_uint(l_reg), false, false); l_reg = __uint_as_float(rr[0]) + __uint_as_float(rr[1]); }
    if (hi == 0) wsf[32 + r32] = l_reg;
    asm volatile("s_waitcnt lgkmcnt(0)" ::: "memory");
    float rli[16];
#pragma unroll
    for (int r = 0; r < 16; ++r) rli[r] = __builtin_amdgcn_rcpf(wsf[32 + crow(r, hi)]);
    bf16* Ow = O + (rowbase + q0 + wid * 32) * 512 + h * VD;
    { LAS bf16* stg = (LAS bf16*)(shm + LDS_OST) + wid * 2048;
#pragma unroll
      for (int r = 0; r < 16; ++r) { const int orow = crow(r, hi);
#pragma unroll
          for (int d0 = 0; d0 < 2; ++d0) stg[orow * 64 + d0 * 32 + r32] = (bf16)f2bf(o[d0][r] * rli[r]); }
      asm volatile("s_waitcnt lgkmcnt(0)" ::: "memory");
#pragma unroll
      for (int i = 0; i < 4; ++i) { const int row = i * 8 + (lane >> 3), ch = lane & 7; const v4u v = *(const LAS v4u*)(stg + row * 64 + ch * 8); *(v4u*)(Ow + (size_t)row * 512 + ch * 8) = v; } }
    asm volatile("s_waitcnt lgkmcnt(0)" ::: "memory");
#undef ATT_GLDS
#undef ATT_DMA
}
}

#define XB_TMO      128
#define XB_XCNT(j)  (256  + 64 * (j))
#define XB_XSUB(j)  (1280 + 64 * (j))
#define XB_XGEN(j)  (2304 + 64 * (j))
#define XB_TOP      3328
#define XB_TOPGEN   3392
#define XCD_BAR_WORDS 3456
#define XB_SPIN_CAP (1u << 22)

__device__ __forceinline__ unsigned xb_ld(unsigned* p)              { return __hip_atomic_load(p, __ATOMIC_RELAXED, __HIP_MEMORY_SCOPE_AGENT); }
__device__ __forceinline__ unsigned xb_add(unsigned* p, unsigned v) { return __hip_atomic_fetch_add(p, v, __ATOMIC_RELAXED, __HIP_MEMORY_SCOPE_AGENT); }
__device__ __forceinline__ unsigned xb_xcc_id() { return (unsigned)__builtin_amdgcn_s_getreg((3 << 11) | 20) & 0xFu; }
#define XB_SPIN(cond, bar) do { unsigned _sp = 0; while (cond) { __builtin_amdgcn_s_sleep(1); \
    if ((++_sp & 255u) == 0u) { if (xb_ld(&(bar)[XB_TMO])) break; if (_sp > XB_SPIN_CAP) { atomicAdd(&(bar)[XB_TMO], 1u); break; } } } } while (0)

struct XcdBarrier { unsigned* bar; unsigned x; volatile LAS unsigned* st; };
__device__ __forceinline__ XcdBarrier xcd_barrier_post(unsigned* bar, volatile LAS unsigned* st) {
    XcdBarrier b; b.bar = bar; b.x = xb_xcc_id(); b.st = st;
    if (threadIdx.x == 0) (void)xb_add(&bar[XB_XCNT(b.x)], 1u);
    return b;
}
__device__ __forceinline__ void xcd_barrier_complete(unsigned* bar, unsigned x, unsigned& nloc, unsigned& nx) {
    const unsigned G = gridDim.x * gridDim.y * gridDim.z;
    unsigned sum, cnt, mine, sp = 0u;
    for (;;) {
        sum = 0u; cnt = 0u; mine = 0u;
#pragma unroll
        for (unsigned j = 0; j < 16; ++j) { const unsigned c = xb_ld(&bar[XB_XCNT(j)]); sum += c; cnt += (c > 0u) ? 1u : 0u; mine = (j == x) ? c : mine; }
        if (sum == G) break;
        __builtin_amdgcn_s_sleep(1);
        if ((++sp & 255u) == 0u) { if (xb_ld(&bar[XB_TMO])) break; if (sp > XB_SPIN_CAP) { atomicAdd(&bar[XB_TMO], 1u); break; } }
    }
    nloc = mine > 0u ? mine : 1u; nx = cnt > 0u ? cnt : 1u;
}
__device__ __forceinline__ void xcd_barrier(const XcdBarrier& b) {
    asm volatile("s_waitcnt vmcnt(0)" ::: "memory");
    __syncthreads();
    if (threadIdx.x == 0) {
        unsigned* bar = b.bar;
        __builtin_amdgcn_s_waitcnt(0);
        unsigned nloc = b.st[0], nx = b.st[1];
        if (nloc == 0u) { xcd_barrier_complete(bar, b.x, nloc, nx); b.st[0] = nloc; b.st[1] = nx; }
        const unsigned old = xb_add(&bar[XB_XSUB(b.x)], 1u);
        const unsigned gen = old / nloc;
        if (old + 1u == (gen + 1u) * nloc) {
            __builtin_amdgcn_fence(__ATOMIC_RELEASE, "agent");
            asm volatile("s_waitcnt vmcnt(0)" ::: "memory");
            const unsigned og = xb_add(&bar[XB_TOP], 1u);
            const unsigned tg = og / nx;
            if (og + 1u == (tg + 1u) * nx) xb_add(&bar[XB_TOPGEN], 1u);
            else XB_SPIN(xb_ld(&bar[XB_TOPGEN]) == tg, bar);
            __builtin_amdgcn_fence(__ATOMIC_ACQUIRE, "agent");
            xb_add(&bar[XB_XGEN(b.x)], 1u);
            asm volatile("s_waitcnt vmcnt(0)" ::: "memory");
        } else {
            XB_SPIN(xb_ld(&bar[XB_XGEN(b.x)]) == gen, bar);
            __builtin_amdgcn_fence(__ATOMIC_ACQUIRE, "agent");
            asm volatile("s_waitcnt vmcnt(0)" ::: "memory");
        }
    }
    __syncthreads();
}

constexpr int NWAVES = 8;
struct Params {
    const float* in[21];
    float* out; unsigned char* ws;
    int ph_lo, ph_hi;
};
struct Frame {
    LAS unsigned char* lds; volatile LAS unsigned* MISC;
    int tid, lane, wave, vcu, G;
    unsigned char* ws; unsigned char* outb;
};

__device__ __forceinline__ void frame_ids(Frame& F) { F.tid = opaque_tid(); F.lane = F.tid & 63; F.wave = __builtin_amdgcn_readfirstlane(F.tid >> 6); }
__device__ __forceinline__ int il32(int j) { return j < 16 ? 2 * j : 2 * (j - 16) + 1; }
__device__ __forceinline__ int maprow(int kind, int n) {
    switch (kind) {
    case 1: return n < C_KPE ? n : (n < C_KPE + 32 ? C_KPE + il32(n - C_KPE) : n + 96);
    case 2: { const int h = n / 96, j = n - h * 96; return j < 64 ? h * 64 + j : 512 + h * 32 + il32(j - 64); }
    case 3: { const int h = n >> 7, j = n & 127; return j < 64 ? h * 64 + j : 512 + h * 64 + (j - 64); }
    case 4: return (n >> 7) * 256 + (n & 127);
    case 5: return (n >> 7) * 256 + 128 + (n & 127);
    default: return n; }
}
__device__ __forceinline__ void p0_transpose_item(const float* W, int K, int N, bf16* WT, const float* kscale, int kind, LAS float* scr, int item, int lane) {
    const int nblk = N / 32, kb = item / nblk, nb = item % nblk, k0 = 64 * kb, n0 = 32 * nb;
#pragma unroll 8
    for (int i = 0; i < 32; ++i) { const int kk = 2 * i + (lane >> 5); float v = W[(size_t)(k0 + kk) * N + n0 + (lane & 31)]; if (kscale) v *= kscale[k0 + kk]; scr[kk * 33 + (lane & 31)] = v; }
    LDS_WAIT(); asm volatile("" ::: "memory");
    const int c = lane & 7;
#pragma unroll
    for (int j = 0; j < 4; ++j) { const int n = (lane >> 3) + 8 * j; const LAS float* s = scr + (8 * c) * 33 + n;
        v4u o; o.x = pk2(s[0 * 33], s[1 * 33]); o.y = pk2(s[2 * 33], s[3 * 33]); o.z = pk2(s[4 * 33], s[5 * 33]); o.w = pk2(s[6 * 33], s[7 * 33]);
        *(GAS v4u*)(WT + (size_t)maprow(kind, n0 + n) * K + k0 + 8 * c) = o; }
    LDS_WAIT(); asm volatile("" ::: "memory");
}
__device__ __forceinline__ void p0_prologue(Frame& F, const Params& P) {
    LAS float* scr = (LAS float*)(F.lds + RING_OFF + F.wave * 16384);
    const int gw = F.vcu * NWAVES + F.wave, NGW = F.G * NWAVES;
    unsigned char* ws = F.ws;
    constexpr int I_IN = 16 * 101, I_POOL = 64, I_UQ = 6 * 24, I_UKV = 4 * 32, I_MLAO = 8 * 32, I_OUT = 16 * 32, I_GE = 16 * 16, I_G = 32 * I_GE, I_DE = 8 * 32, I_D = 32 * I_DE;
    constexpr int NITEMS = I_IN + I_POOL + I_UQ + I_UKV + I_MLAO + I_OUT + 2 * I_G + I_D;
    for (int it = gw; it < NITEMS; it += NGW) {
        int r = it;
        if (r < I_IN) { p0_transpose_item(P.in[1], 1024, 3232, (bf16*)(ws + W_IN_T), nullptr, 1, scr, r, F.lane); continue; } r -= I_IN;
        if (r < I_POOL) { const int g = r >> 4; p0_transpose_item(P.in[2] + (size_t)g * 128 * 256, 128, 256, (bf16*)(ws + W_POOL_T) + (size_t)g * 256 * 128, nullptr, 0, scr, r & 15, F.lane); continue; } r -= I_POOL;
        if (r < I_UQ) { p0_transpose_item(P.in[5], 384, 768, (bf16*)(ws + W_UQ_T), P.in[4], 2, scr, r, F.lane); continue; } r -= I_UQ;
        if (r < I_UKV) { p0_transpose_item(P.in[7], 256, 1024, (bf16*)(ws + W_UKV_T), P.in[6], 3, scr, r, F.lane); continue; } r -= I_UKV;
        if (r < I_MLAO) { p0_transpose_item(P.in[8], 512, 1024, (bf16*)(ws + W_MLAO_T), nullptr, 0, scr, r, F.lane); continue; } r -= I_MLAO;
        if (r < I_OUT) { p0_transpose_item(P.in[9], 1024, 1024, (bf16*)(ws + W_OUT_T), nullptr, 0, scr, r, F.lane); continue; } r -= I_OUT;
        if (r < I_G) { const int e = r / I_GE; p0_transpose_item(P.in[16] + (size_t)e * 1024 * 512, 1024, 512, (bf16*)(ws + W_GU_T) + (size_t)e * 1024 * 1024, nullptr, 4, scr, r % I_GE, F.lane); continue; } r -= I_G;
        if (r < I_G) { const int e = r / I_GE; p0_transpose_item(P.in[17] + (size_t)e * 1024 * 512, 1024, 512, (bf16*)(ws + W_GU_T) + (size_t)e * 1024 * 1024, nullptr, 5, scr, r % I_GE, F.lane); continue; } r -= I_G;
        { const int e = r / I_DE; p0_transpose_item(P.in[18] + (size_t)e * 512 * 1024, 512, 1024, (bf16*)(ws + W_DN_T) + (size_t)e * 1024 * 512, nullptr, 0, scr, r % I_DE, F.lane); }
    }
    const int gt = (F.vcu * NWAVES + F.wave) * 64 + F.lane, NGT = NGW * 64;
    for (int i = gt; i < 96 * 1024 / 8; i += NGT) *(GAS v4u*)((bf16*)(ws + W_IN_T) + (size_t)1184 * 1024 + (size_t)i * 8) = (v4u){0u, 0u, 0u, 0u};
    for (int i = gt; i < 48 * 1024; i += NGT) { const int c = i >> 10, k = i & 1023; float v = 0.f; if (c < 4) v = P.in[12][k * 4 + c]; else if (c < 36) v = P.in[14][k * 32 + (c - 4)];
        ((bf16*)(ws + W_ROUTER_T))[i] = (bf16)f2bf(v); }
    for (int i = gt; i < SEQ * 16; i += NGT) { const int pos = i >> 4, p = i & 15; const float inv = 1.0f / powf(10000.0f, (float)(2 * p) / 32.0f); const float ang = (float)pos * inv;
        const double rev = (double)ang * 0.15915494309189533577; const float fr = (float)(rev - floor(rev));
        ((f32x2*)(ws + SM_ROPE))[i] = (f32x2){__builtin_amdgcn_cosf(fr), __builtin_amdgcn_sinf(fr)}; }
    { const float* x = P.in[0]; bf16* xb = (bf16*)(ws + WS_XB);
      for (int i = gt; i < M * D / 8; i += NGT) { const f32x4 a = *(const GAS f32x4*)(x + (size_t)i * 8), b = *(const GAS f32x4*)(x + (size_t)i * 8 + 4);
          v4u o; o.x = pk2(a.x, a.y); o.y = pk2(a.z, a.w); o.z = pk2(b.x, b.y); o.w = pk2(b.z, b.w); *(GAS v4u*)(xb + (size_t)i * 8) = o; } }
}

__device__ __forceinline__ void unpack8f(const v4u& w, float (&f)[8]) { f[0] = bflo(w.x); f[1] = bfhi(w.x); f[2] = bflo(w.y); f[3] = bfhi(w.y); f[4] = bflo(w.z); f[5] = bfhi(w.z); f[6] = bflo(w.w); f[7] = bfhi(w.w); }
__device__ __forceinline__ void p2_thin(Frame& F) {
    const bf16* PB = (const bf16*)(F.ws + WS_PB); bf16* pooled = (bf16*)(F.ws + WS_POOLED); bf16* Kf = (bf16*)(F.ws + WS_K);
    float* rq = (float*)(F.ws + SM_RQ); float* rkv = (float*)(F.ws + SM_RKV); const f32x2* rope = (const f32x2*)(F.ws + SM_ROPE);
    const int l = F.lane;
    for (int blk = blockIdx.x; blk < M / 128; blk += F.G) {
        const int t0 = blk * 128 + F.wave * 16, pos0 = t0 & (SEQ - 1);
        { const int g = l >> 4, W = 2 << g; const bf16* up = PB + (size_t)t0 * PBW + 8 * l;
          float sum[8];
#pragma unroll
          for (int j = 0; j < 8; ++j) sum[j] = 0.f;
#pragma unroll
          for (int j = 1; j < 16; ++j) { if (j < W && pos0 - j >= 0) { const v4u w = *(const GAS v4u*)(up - (ptrdiff_t)j * PBW); float f[8]; unpack8f(w, f);
#pragma unroll
                  for (int e = 0; e < 8; ++e) sum[e] += f[e]; } }
#pragma unroll 4
          for (int i = 0; i < 16; ++i) { const v4u cw = *(const GAS v4u*)(up + (size_t)i * PBW); float cur[8]; unpack8f(cw, cur);
              const int pos = pos0 + i; const int cnt = (pos + 1 < W) ? pos + 1 : W; const float inv = 1.0f / (float)cnt; float o[8];
#pragma unroll
              for (int e = 0; e < 8; ++e) { sum[e] += cur[e]; o[e] = sum[e] * inv - cur[e]; }
              v4u ow; ow.x = pk2(o[0], o[1]); ow.y = pk2(o[2], o[3]); ow.z = pk2(o[4], o[5]); ow.w = pk2(o[6], o[7]);
              *(GAS v4u*)(pooled + (size_t)(t0 + i) * 512 + 8 * l) = ow;
              if (pos - W + 1 >= 0) { const v4u w = *(const GAS v4u*)(up + (ptrdiff_t)(i - W + 1) * PBW); float f[8]; unpack8f(w, f);
#pragma unroll
                  for (int e = 0; e < 8; ++e) sum[e] -= f[e]; } } }
#pragma unroll 4
        for (int i = 0; i < 16; ++i) { const int t = t0 + i; const bf16* row = PB + (size_t)t * PBW; float sq = 0.f, sk = 0.f;
            if (l < 48) { const v4u w = *(const GAS v4u*)(row + C_CQ + 8 * l); float f[8]; unpack8f(w, f);
#pragma unroll
                for (int e = 0; e < 8; ++e) sq += f[e] * f[e]; }
            if (l < 32) { const v4u w = *(const GAS v4u*)(row + C_CKV + 8 * l); float f[8]; unpack8f(w, f);
#pragma unroll
                for (int e = 0; e < 8; ++e) sk += f[e] * f[e]; }
            sq = wave_sum(sq); sk = wave_sum(sk);
            if (l == 0) { rq[t] = 1.0f / sqrtf(sq * (1.0f / 384.0f) + EPS); rkv[t] = 1.0f / sqrtf(sk * (1.0f / 256.0f) + EPS); }
            if (l < 16) { const unsigned w = *(const GAS unsigned*)(row + C_KPE + 2 * l); const float x1 = bflo(w), x2 = bfhi(w); const f32x2 cs = rope[(size_t)(t & (SEQ - 1)) * 16 + l];
                const unsigned ow = pk2(x1 * cs.x - x2 * cs.y, x1 * cs.y + x2 * cs.x);
#pragma unroll
                for (int h = 0; h < NH; ++h) *(GAS unsigned*)(Kf + (size_t)t * QP + h * QKD + 64 + 2 * l) = ow; } }
    }
}

__device__ __forceinline__ void p7_ln_router(Frame& F, const Params& P) {
    const bf16* VH = (const bf16*)(F.ws + WS_VH); bf16* H = (bf16*)(F.ws + WS_H); const float* stats = (const float*)(F.ws + SM_STATS); const bf16* RT = (const bf16*)(F.ws + W_ROUTER_T);
    v4u* recs = (v4u*)(F.ws + SM_RECS); int* blkcnt = (int*)(F.ws + SM_BLKCNT);
    const float* g1 = P.in[10]; const float* b1 = P.in[11]; const float* brg = P.in[13]; const float* bre = P.in[15];
    LAS float* lg = (LAS float*)(F.lds + F.wave * 3072); LAS unsigned* hist = (LAS unsigned*)(F.lds + 32768);
    const int l = F.lane, r = l & 15, q = l >> 4;
    LAS float* gb = (LAS float*)(F.lds + 40960);
    { const int i = F.tid; ((LAS f32x4*)gb)[i] = (i < 256) ? *(const GAS f32x4*)(g1 + 4 * i) : *(const GAS f32x4*)(b1 + 4 * (i - 256)); }
    for (int blk = blockIdx.x; blk < M / 128; blk += F.G) {
        if (F.tid < 32) hist[F.tid] = 0u;
        __syncthreads();
        const int t = blk * 128 + F.wave * 16 + r;
        const bf16* vrow = VH + (size_t)t * D; bf16* hrow = H + (size_t)t * D;
        float mean, rstd;
        { const float* st = stats + (size_t)t * 32 + q * 8; const f32x4 a = *(const GAS f32x4*)st, b = *(const GAS f32x4*)(st + 4);
          float s = (a.x + a.z) + (b.x + b.z), qq = (a.y + a.w) + (b.y + b.w);
          s += __shfl_xor(s, 16); s += __shfl_xor(s, 32); qq += __shfl_xor(qq, 16); qq += __shfl_xor(qq, 32);
          mean = s * (1.0f / 1024.0f); const float var = qq * (1.0f / 1024.0f) - mean * mean; rstd = 1.0f / sqrtf(var + EPS); }
        f32x4 acc[3]; acc[0] = (f32x4){0.f, 0.f, 0.f, 0.f}; acc[1] = acc[0]; acc[2] = acc[0];
#pragma unroll 1
        for (int ch = 0; ch < 4; ++ch) {
            v4u vw[8];
#pragma unroll
            for (int j = 0; j < 8; ++j) vw[j] = *(const GAS v4u*)(vrow + 256 * ch + 32 * j + 8 * q);
#pragma unroll
            for (int j = 0; j < 8; ++j) { const int c0 = 256 * ch + 32 * j + 8 * q;
                float f[8]; unpack8f(vw[j], f);
                const f32x4 ga = *(const LAS f32x4*)(gb + c0), gbv = *(const LAS f32x4*)(gb + c0 + 4), ba = *(const LAS f32x4*)(gb + 1024 + c0), bb = *(const LAS f32x4*)(gb + 1024 + c0 + 4);
                float hv[8];
#pragma unroll
                for (int e = 0; e < 4; ++e) { hv[e] = (f[e] - mean) * rstd * ga[e] + ba[e]; hv[4 + e] = (f[4 + e] - mean) * rstd * gbv[e] + bb[e]; }
                v4u hw; hw.x = pk2(hv[0], hv[1]); hw.y = pk2(hv[2], hv[3]); hw.z = pk2(hv[4], hv[5]); hw.w = pk2(hv[6], hv[7]);
                *(GAS v4u*)(hrow + c0) = hw;
                const bf16x8 af = __builtin_bit_cast(bf16x8, hw);
#pragma unroll
                for (int ct = 0; ct < 3; ++ct) { const bf16x8 bfr = *(const GAS bf16x8*)(RT + (size_t)(16 * ct + r) * D + c0); acc[ct] = __builtin_amdgcn_mfma_f32_16x16x32_bf16(af, bfr, acc[ct], 0, 0, 0); } }
        }
#pragma unroll
        for (int ct = 0; ct < 3; ++ct)
#pragma unroll
            for (int j = 0; j < 4; ++j) lg[(4 * q + j) * 48 + 16 * ct + r] = acc[ct][j];
        LDS_WAIT(); asm volatile("" ::: "memory");
        if (l < 16) { const LAS float* lp = lg + l * 48; const int tok = blk * 128 + F.wave * 16 + l;
            float gl[4];
#pragma unroll
            for (int j = 0; j < 4; ++j) gl[j] = lp[j] + brg[j];
            int gi = 0; float gm = gl[0];
#pragma unroll
            for (int j = 1; j < 4; ++j) if (gl[j] > gm) { gm = gl[j]; gi = j; }
            float gs = 0.f;
#pragma unroll
            for (int j = 0; j < 4; ++j) gs += __expf(gl[j] - gm);
            const float gw_ = 1.0f / gs;
            float el[8];
#pragma unroll
            for (int j = 0; j < 8; ++j) el[j] = lp[4 + 8 * gi + j] + bre[8 * gi + j];
            int i1 = 0; float m1 = el[0];
#pragma unroll
            for (int j = 1; j < 8; ++j) if (el[j] > m1) { m1 = el[j]; i1 = j; }
            int i2 = -1; float m2 = -3.0e38f;
#pragma unroll
            for (int j = 0; j < 8; ++j) if (j != i1 && el[j] > m2) { m2 = el[j]; i2 = j; }
            const float p2 = __expf(m2 - m1), den = 1.0f / (1.0f + p2);
            const float w1 = gw_ * den, w2 = gw_ * p2 * den; const int e1 = 8 * gi + i1, e2 = 8 * gi + i2;
            recs[tok] = (v4u){(unsigned)e1, (unsigned)e2, __float_as_uint(w1), __float_as_uint(w2)};
            atomicAdd((unsigned*)&hist[e1], 1u); atomicAdd((unsigned*)&hist[e2], 1u); }
        __syncthreads();
        if (F.tid < 32) blkcnt[blk * 32 + F.tid] = (int)hist[F.tid];
        __syncthreads();
    }
}

__device__ __forceinline__ void p8_scatter(Frame& F) {
    const v4u* recs = (const v4u*)(F.ws + SM_RECS); const int* blkcnt = (const int*)(F.ws + SM_BLKCNT);
    int* row_tok = (int*)(F.ws + SM_ROWTOK); float* row_w = (float*)(F.ws + SM_ROWW); int* rowof = (int*)(F.ws + SM_ROWOF); int* pinfo = (int*)(F.ws + SM_PINFO);
    LAS int* part_tot = (LAS int*)(F.lds);
    LAS int* part_pre = (LAS int*)(F.lds + 2048);
    LAS int* cnt = (LAS int*)(F.lds + 4096);
    LAS int* base = (LAS int*)(F.lds + 4224);
    LAS int* pstart = (LAS int*)(F.lds + 4352);
    LAS int* exps = (LAS int*)(F.lds + 4608);
    const int nblk = M / 128;
    for (int blk = blockIdx.x; blk < nblk; blk += F.G) {
        { const int e = F.tid & 31, part = F.tid >> 5; int tot = 0, pre = 0;
          for (int b = part * 16; b < part * 16 + 16; ++b) { const int c = blkcnt[b * 32 + e]; tot += c; if (b < blk) pre += c; }
          part_tot[part * 32 + e] = tot; part_pre[part * 32 + e] = pre; }
        __syncthreads();
        if (F.tid < 32) { int tot = 0, pre = 0;
#pragma unroll
            for (int p = 0; p < 16; ++p) { tot += part_tot[p * 32 + F.tid]; pre += part_pre[p * 32 + F.tid]; }
            cnt[F.tid] = tot; base[F.tid] = pre; }
        __syncthreads();
        if (F.tid == 0) { int s = 0; for (int e = 0; e < 32; ++e) { pstart[e] = s; s += (cnt[e] + 255) & ~255; } pstart[32] = s; }
        __syncthreads();
        int e_a = 0, tok = 0, k = 0; float w_a = 0.f;
        if (F.tid < 256) { tok = blk * 128 + (F.tid >> 1); k = F.tid & 1; const v4u rc = recs[tok]; e_a = (int)(k ? rc.y : rc.x); w_a = __uint_as_float(k ? rc.w : rc.z); exps[F.tid] = e_a; }
        __syncthreads();
        if (F.tid < 256) { int rank = 0; for (int a = 0; a < F.tid; ++a) rank += (exps[a] == e_a) ? 1 : 0;
            const int dest = pstart[e_a] + base[e_a] + rank; row_tok[dest] = tok; row_w[dest] = w_a; rowof[tok * 2 + k] = dest; }
        if (blk < 32) { const int e = blk; for (int r = pstart[e] + cnt[e] + F.tid; r < pstart[e + 1]; r += NWAVES * 64) { row_tok[r] = 0; row_w[r] = 0.f; } }
        if (blk == 0) { const int np = pstart[32] >> 8; if (F.tid == 0) pinfo[0] = np;
            for (int p = F.tid; p < np; p += NWAVES * 64) { int e = 0; for (int j = 1; j < 32; ++j) if (pstart[j] <= p * 256) e = j; pinfo[16 + p] = e; } }
        __syncthreads();
    }
}
__device__ __forceinline__ void load_pexp(Frame& F) {
    const int* pinfo = (const int*)(F.ws + SM_PINFO); LAS int* px = (LAS int*)(F.lds + PEXP_OFF);
    for (int i = F.tid; i < 16 + 288; i += NWAVES * 64) px[i] = __hip_atomic_load(pinfo + i, RLX_AGENT);
    __syncthreads();
}

__device__ __forceinline__ void p11_final(Frame& F, const Params& P) {
    const bf16* H = (const bf16*)(F.ws + WS_H); const bf16* Y = (const bf16*)(F.ws + WS_Y); const int* rowof = (const int*)(F.ws + SM_ROWOF);
    const float* g2 = P.in[19]; const float* b2 = P.in[20]; float* out = P.out;
    const int gw = F.vcu * NWAVES + F.wave, NGW = F.G * NWAVES, l = F.lane;
    f32x4 gg[4], bb[4];
#pragma unroll
    for (int j = 0; j < 2; ++j) { gg[2 * j] = *(const GAS f32x4*)(g2 + 512 * j + 8 * l); gg[2 * j + 1] = *(const GAS f32x4*)(g2 + 512 * j + 8 * l + 4);
        bb[2 * j] = *(const GAS f32x4*)(b2 + 512 * j + 8 * l); bb[2 * j + 1] = *(const GAS f32x4*)(b2 + 512 * j + 8 * l + 4); }
    for (int rb = gw * 16; rb < M; rb += NGW * 16) {
        const int myidx = (l < 32) ? rowof[rb * 2 + l] : 0;
#pragma unroll 1
        for (int i = 0; i < 16; i += 2) {
            float z[2][16];
#pragma unroll
            for (int u = 0; u < 2; ++u) { const int row = rb + i + u; const int r1 = __shfl(myidx, 2 * (i + u)), r2 = __shfl(myidx, 2 * (i + u) + 1);
#pragma unroll
                for (int j = 0; j < 2; ++j) { const v4u hw = *(const GAS v4u*)(H + (size_t)row * D + 512 * j + 8 * l), y1 = *(const GAS v4u*)(Y + (size_t)r1 * D + 512 * j + 8 * l), y2 = *(const GAS v4u*)(Y + (size_t)r2 * D + 512 * j + 8 * l);
                    float hf[8], a[8], b[8]; unpack8f(hw, hf); unpack8f(y1, a); unpack8f(y2, b);
#pragma unroll
                    for (int e = 0; e < 8; ++e) z[u][8 * j + e] = ALPHA * hf[e] + (a[e] + b[e]); } }
#pragma unroll
            for (int u = 0; u < 2; ++u) { const int row = rb + i + u; float s = 0.f;
#pragma unroll
                for (int e = 0; e < 16; ++e) s += z[u][e];
                const float mean = wave_sum(s) * (1.0f / 1024.0f); float s2 = 0.f;
#pragma unroll
                for (int e = 0; e < 16; ++e) { z[u][e] -= mean; s2 += z[u][e] * z[u][e]; }
                const float rstd = 1.0f / sqrtf(wave_sum(s2) * (1.0f / 1024.0f) + EPS);
#pragma unroll
                for (int j = 0; j < 2; ++j) { f32x4 o0, o1;
#pragma unroll
                    for (int e = 0; e < 4; ++e) { o0[e] = z[u][8 * j + e] * rstd * gg[2 * j][e] + bb[2 * j][e]; o1[e] = z[u][8 * j + 4 + e] * rstd * gg[2 * j + 1][e] + bb[2 * j + 1][e]; }
                    *(GAS f32x4*)(out + (size_t)row * D + 512 * j + 8 * l) = o0; *(GAS f32x4*)(out + (size_t)row * D + 512 * j + 8 * l + 4) = o1; } }
        }
    }
}

__device__ __forceinline__ void attn_phase(Frame& F) {
    const bf16* Q = (const bf16*)(F.outb + OUT_Q); const bf16* K = (const bf16*)(F.ws + WS_K); const bf16* V = (const bf16*)(F.ws + WS_V); bf16* O = (bf16*)(F.ws + WS_O);
    for (int v = F.vcu; v < 256; v += F.G) {
        const int s = v & 7, bh = v >> 3;
#pragma unroll 1
        for (int i = 0; i < 4; ++i) { const int qb = (i == 0) ? s : (i == 1) ? 15 - s : (i == 2) ? 16 + s : 31 - s;
            attn::attn_unit<8>(bh >> 3, bh & 7, qb, Q, K, V, O, F.lds + RING_OFF); }
    }
    __syncthreads();
}

constexpr int N_PHASES = 12;
__global__ void __launch_bounds__(NWAVES * 64, 2) mk_fwd(Params P) {
    extern __shared__ __attribute__((aligned(16))) unsigned char lds_raw[];
    Frame F;
    F.lds = (LAS unsigned char*)lds_raw;
    F.MISC = (volatile LAS unsigned*)(F.lds + MISC_OFF);
    frame_ids(F);
    F.G = gridDim.x; { const int bx = blockIdx.x; F.vcu = (F.G % 8 == 0) ? (bx % 8) * (F.G / 8) + bx / 8 : bx; }
    F.ws = P.ws; F.outb = (unsigned char*)P.out;
    unsigned char* ws = P.ws;
    for (int u = F.tid; u < (LDS_BYTES - LDSCTL_OFF) / 4; u += NWAVES * 64) ((LAS unsigned*)(F.lds + LDSCTL_OFF))[u] = 0u;
    __syncthreads();
    XcdBarrier bar; bar.bar = (unsigned*)(ws + WS_CTL) + CW_BAR; bar.x = 0; bar.st = nullptr;
    if (MK_N_LAUNCHES == 1) bar = xcd_barrier_post((unsigned*)(ws + WS_CTL) + CW_BAR, F.MISC + 8);
    const int lo = P.ph_lo, hi = P.ph_hi;
#define IN(k) (lo <= (k) && (k) < hi)
#define SEAM(k) do { if (IN(k) && IN((k) + 1)) xcd_barrier(bar); } while (0)
    typedef pg8::StaticOrder SO;
#define PH_BEGIN(k) if (IN(k)) { _Pragma("unroll") for (int rep_ = 0; rep_ < (((PROBE_REPEAT_MASK) >> (k)) & 1) + 1; ++rep_) { if (rep_) xcd_barrier(bar);
#define PH_END(k) } } SEAM(k);

    PH_BEGIN(0) frame_ids(F); p0_prologue(F, P); PH_END(0)

    PH_BEGIN(1)
        pg8::OpsPlain G{(const char*)(ws + WS_XB), (const char*)(ws + W_IN_T), 1024, 1024, 0}; SO S; S.init(M / 256, PBW / 256, F.G, (int)blockIdx.x);
        pg8::EpiProj E{(bf16*)(ws + WS_PB)};
        pg8::gemm_phase<pg8::EpiProj, SO, pg8::OpsPlain, true>(F.lds + RING_OFF, G, S, E);
    PH_END(1)

    PH_BEGIN(2) frame_ids(F); p2_thin(F); PH_END(2)

    PH_BEGIN(3)
        {
          pg8::OpsPlain G{(const char*)(ws + WS_POOLED), (const char*)(ws + W_POOL_T), 128, 512, 256}; SO S; S.init(M / 256, 4, F.G, (int)blockIdx.x);
          pg8::EpiPool E{(bf16*)(F.outb + OUT_TP), (const bf16*)(ws + WS_PB), P.in[3]};
          pg8::gemm_phase<pg8::EpiPool, SO, pg8::OpsPlain, true>(F.lds + RING_OFF, G, S, E); }
        __syncthreads();
        {
          pg8::OpsPlain G{(const char*)(ws + WS_PB) + C_CQ * 2, (const char*)(ws + W_UQ_T), 384, PBW, 0}; SO S; S.init(M / 256, 3, F.G, (int)blockIdx.x);
          pg8::EpiQ E{(bf16*)(F.outb + OUT_Q), (const float*)(ws + SM_RQ), (const float*)(ws + SM_ROPE)};
          pg8::gemm_phase<pg8::EpiQ, SO, pg8::OpsPlain, true>(F.lds + RING_OFF, G, S, E); }
        __syncthreads();
        {
          pg8::OpsPlain G{(const char*)(ws + WS_PB) + C_CKV * 2, (const char*)(ws + W_UKV_T), 256, PBW, 0}; SO S; S.init(M / 256, 4, F.G, (int)blockIdx.x);
          pg8::EpiKV E{(bf16*)(ws + WS_K), (bf16*)(ws + WS_V), (const float*)(ws + SM_RKV)};
          pg8::gemm_phase<pg8::EpiKV, SO, pg8::OpsPlain, true>(F.lds + RING_OFF, G, S, E); }
    PH_END(3)

    PH_BEGIN(4) frame_ids(F); attn_phase(F); PH_END(4)

    PH_BEGIN(5)
        pg8::OpsPlain G{(const char*)(ws + WS_O), (const char*)(ws + W_MLAO_T), 512, 512, 0}; SO S; S.init(M / 256, 4, F.G, (int)blockIdx.x);
        pg8::EpiMla E{(bf16*)(F.outb + OUT_TP), (const bf16*)(ws + WS_PB)};
        pg8::gemm_phase<pg8::EpiMla, SO, pg8::OpsPlain, true>(F.lds + RING_OFF, G, S, E);
    PH_END(5)

    PH_BEGIN(6)
        pg8::OpsPlain G{(const char*)(F.outb + OUT_TP), (const char*)(ws + W_OUT_T), 1024, 1024, 0}; SO S; S.init(M / 256, 4, F.G, (int)blockIdx.x);
        pg8::EpiOut E{(bf16*)(ws + WS_VH), P.in[0], (float*)(ws + SM_STATS)};
        pg8::gemm_phase<pg8::EpiOut, SO, pg8::OpsPlain, true>(F.lds + RING_OFF, G, S, E);
    PH_END(6)

    PH_BEGIN(7) frame_ids(F); p7_ln_router(F, P); PH_END(7)
    PH_BEGIN(8) frame_ids(F); p8_scatter(F); PH_END(8)

    PH_BEGIN(9)
        frame_ids(F); load_pexp(F); const LAS int* px = (const LAS int*)(F.lds + PEXP_OFF); const int np = px[0];
        pg8::OpsMoe1 G{(const char*)(ws + WS_H), (const char*)(ws + W_GU_T), 1024, 1024, (const int*)(ws + SM_ROWTOK), px}; SO S; S.init(np, 4, F.G, (int)blockIdx.x);
        pg8::EpiHid E{(bf16*)(ws + WS_HID)};
        pg8::gemm_phase<pg8::EpiHid, SO, pg8::OpsMoe1, true>(F.lds + RING_OFF, G, S, E);
    PH_END(9)

    PH_BEGIN(10)
        frame_ids(F); load_pexp(F); const LAS int* px = (const LAS int*)(F.lds + PEXP_OFF); const int np = px[0];
        pg8::OpsMoe2 G{(const char*)(ws + WS_HID), (const char*)(ws + W_DN_T), 512, 512, px}; SO S; S.init(np, 4, F.G, (int)blockIdx.x);
        pg8::EpiDown E{(bf16*)(ws + WS_Y), (const float*)(ws + SM_ROWW)};
        pg8::gemm_phase<pg8::EpiDown, SO, pg8::OpsMoe2, true>(F.lds + RING_OFF, G, S, E);
    PH_END(10)

    PH_BEGIN(11) frame_ids(F); p11_final(F, P); } }
#undef IN
#undef SEAM
}

extern "C" void kernel_launch(void* const* d_in, const int* in_sizes, int n_in, void* d_out, int out_size, void* d_ws, size_t ws_size, hipStream_t stream) {
    static int grid = 0;
    if (grid == 0) {
        if (n_in != 21 || out_size != M * D || ws_size < WS_END) { fprintf(stderr, "kernel_launch: unexpected shapes: n_in %d out %d ws %zu\n", n_in, out_size, ws_size); grid = -1; return; }
        int dev = 0, cus = 0, per_cu = 0;
        if (hipGetDevice(&dev) != hipSuccess || hipDeviceGetAttribute(&cus, hipDeviceAttributeMultiprocessorCount, dev) != hipSuccess) { grid = -1; return; }
        if (hipFuncSetAttribute((const void*)mk_fwd, hipFuncAttributeMaxDynamicSharedMemorySize, LDS_BYTES) != hipSuccess) { fprintf(stderr, "kernel_launch: hipFuncSetAttribute failed\n"); grid = -1; return; }
        if (hipOccupancyMaxActiveBlocksPerMultiprocessor(&per_cu, (const void*)mk_fwd, NWAVES * 64, LDS_BYTES) != hipSuccess || per_cu < 1) { fprintf(stderr, "kernel_launch: occupancy query says %d\n", per_cu); }
        (void)hipGetLastError();
        grid = cus < 256 ? cus : 256;
    }
    if (grid < 0) return;
    (void)hipMemsetAsync((char*)d_ws + WS_CTL, 0, CTL_ZERO_BYTES, stream);
    Params p{};
    for (int i = 0; i < 21; ++i) p.in[i] = (const float*)d_in[i];
    p.out = (float*)d_out; p.ws = (unsigned char*)d_ws;
#if MK_N_LAUNCHES == 1
    p.ph_lo = 0; p.ph_hi = N_PHASES;
    hipLaunchKernelGGL(mk_fwd, dim3(grid), dim3(NWAVES * 64), LDS_BYTES, stream, p);
#else
    for (int k = 0; k < N_PHASES; ++k) { p.ph_lo = k; p.ph_hi = k + 1; hipLaunchKernelGGL(mk_fwd, dim3(grid), dim3(NWAVES * 64), LDS_BYTES, stream, p); }
#endif
}
```

```cpp
#include <hip/hip_runtime.h>
#include <cstdio>
#include <cstdint>

#ifndef PROBE_REPEAT_MASK
#define PROBE_REPEAT_MASK 0
#endif
#ifndef MK_N_LAUNCHES
#define MK_N_LAUNCHES 1
#endif

#define GAS __attribute__((address_space(1)))
#define LAS __attribute__((address_space(3)))
typedef unsigned short bf16;
typedef unsigned v4u __attribute__((ext_vector_type(4)));
typedef unsigned v2u __attribute__((ext_vector_type(2)));
typedef float f32x4 __attribute__((ext_vector_type(4)));
typedef float f32x2 __attribute__((ext_vector_type(2)));
typedef float f32x16 __attribute__((ext_vector_type(16)));
typedef short bf16x8 __attribute__((ext_vector_type(8)));
typedef short s16x4 __attribute__((ext_vector_type(4)));

constexpr int BATCH = 4, SEQ = 8192, D = 1024, M = BATCH * SEQ;
constexpr int NH = 8, QKD = 96, VD = 64;
constexpr int PBW = 3328;
constexpr int C_U = 0, C_CQ = 512, C_CKV = 896, C_KPE = 1152, C_G0 = 1280, C_G1 = 2304;
constexpr int QP = NH * QKD;
constexpr int NEXP = 32, DEXP = 512;
constexpr int RMAX = 73728;
constexpr float EPS = 1e-5f;
constexpr float ALPHA = 1.189207115002721f;
constexpr float LOG2E = 1.4426950408889634f;
constexpr float QSCALE = 0.10206207261596575f * 1.4426950408889634f;

constexpr size_t MiB = 1u << 20, KiB = 1024;
constexpr size_t WS_CTL = 0, CTL_ZERO_BYTES = 1 * MiB;
constexpr size_t WS_SMALL = 1 * MiB;
constexpr size_t SM_RQ = WS_SMALL, SM_RKV = WS_SMALL + 128 * KiB, SM_RECS = WS_SMALL + 256 * KiB, SM_ROWTOK = WS_SMALL + 768 * KiB, SM_ROWW = WS_SMALL + 1088 * KiB,
                 SM_ROWOF = WS_SMALL + 1408 * KiB, SM_BLKCNT = WS_SMALL + 1664 * KiB, SM_PINFO = WS_SMALL + 1696 * KiB, SM_ROPE = WS_SMALL + 1792 * KiB, SM_STATS = WS_SMALL + 3072 * KiB;
constexpr size_t WS_W = 8 * MiB;
constexpr size_t W_IN_T = WS_W, W_POOL_T = WS_W + 7 * MiB, W_UQ_T = WS_W + 7 * MiB + 256 * KiB, W_UKV_T = WS_W + 8 * MiB, W_ROUTER_T = WS_W + 8 * MiB + 512 * KiB,
                 W_MLAO_T = WS_W + 9 * MiB, W_OUT_T = WS_W + 10 * MiB, W_GU_T = WS_W + 12 * MiB, W_DN_T = WS_W + 76 * MiB;
constexpr size_t WS_XB = 120 * MiB;
constexpr size_t WS_POOLED = WS_XB, WS_O = WS_XB + 32 * MiB, WS_H = WS_XB;
constexpr size_t WS_PB = 184 * MiB;
constexpr size_t WS_Y = WS_PB, WS_VH = WS_PB + 144 * MiB;
constexpr size_t WS_K = 392 * MiB, WS_V = 440 * MiB;
constexpr size_t WS_HID = WS_K;
constexpr size_t WS_END = 472 * MiB;
constexpr size_t OUT_TP = 0, OUT_Q = 64 * MiB;

constexpr int CW_TMO = 0, CW_BAR = 4096;

constexpr int RING_OFF = 0, RING_BYTES = 131072;
constexpr int LDSCTL_OFF = RING_BYTES, MISC_OFF = LDSCTL_OFF + 320, PEXP_OFF = LDSCTL_OFF + 512;
constexpr int LDS_BYTES = 147456;

#define RLX_AGENT __ATOMIC_RELAXED, __HIP_MEMORY_SCOPE_AGENT
#define LDS_WAIT() asm volatile("s_waitcnt lgkmcnt(0)" ::: "memory")
#define VM_WAIT() asm volatile("s_waitcnt vmcnt(0)" ::: "memory")
__device__ __forceinline__ unsigned f2bf(float f) { unsigned u = __builtin_bit_cast(unsigned, f); return (u + 0x7fffu + ((u >> 16) & 1u)) >> 16; }
__device__ __forceinline__ unsigned pk2(float lo, float hi) { return f2bf(lo) | (f2bf(hi) << 16); }
__device__ __forceinline__ float bflo(unsigned w) { return __uint_as_float(w << 16); }
__device__ __forceinline__ float bfhi(unsigned w) { return __uint_as_float(w & 0xffff0000u); }
__device__ __forceinline__ float fast_sigmoid(float x) { return __builtin_amdgcn_rcpf(1.0f + __builtin_amdgcn_exp2f(-x * LOG2E)); }
__device__ __forceinline__ int opaque_tid() { int t = (int)threadIdx.x; asm volatile("" : "+v"(t)); return t; }
__device__ __forceinline__ float wave_sum(float v) {
#pragma unroll
    for (int o = 1; o < 64; o <<= 1) v += __shfl_xor(v, o);
    return v;
}

namespace pg8 {
#define PG8_LAS __attribute__((address_space(3)))
typedef unsigned short bf16_t;
typedef unsigned u32x4 __attribute__((ext_vector_type(4)));
constexpr int BM = 256, BK = 64, HALF = 128, HTB = HALF * BK * 2, STAGE_BYTES = 8 * HTB, NXCD = 8, WGM = 8;

__host__ __device__ __forceinline__ int lds_byte(int r, int c) { const int st = (r >> 4) * 2 + (c >> 5), rr = r & 15, cc = c & 31, ob = rr * 64 + cc * 2; return st * 1024 + (ob ^ (((ob >> 9) & 1) << 5)); }
__host__ __device__ __forceinline__ void stage_rc(int b, int& R, int& C) { const int st = b / 1024, sb = b % 1024, swz = sb ^ (((sb >> 9) & 1) << 5); R = (st >> 1) * 16 + swz / 64; C = (st & 1) * 32 + (swz % 64) / 2; }
__host__ __device__ __forceinline__ int perm32(int rho) { const int n = rho >> 4, i = rho & 15; return 8 * (i >> 2) + 4 * n + (i & 3); }

struct Unit { int pm, pn; };

struct StaticOrder {
    int nM, nN, nwg, G, c;
    __host__ __device__ void init(int nM_, int nN_, int G_, int c_) { nM = nM_; nN = nN_; nwg = nM * nN; G = G_; c = c_; }
    __host__ __device__ bool next(int i, Unit& u) const {
        const long L = (long)i * G + c; if (L >= nwg) return false;
        int wgid = (int)L; { const int q = nwg / NXCD, r = nwg % NXCD, xcd = wgid % NXCD, off = wgid / NXCD; wgid = (xcd < r ? xcd * (q + 1) : r * (q + 1) + (xcd - r) * q) + off; }
        const int nig = WGM * nN, gid = wgid / nig, fm = gid * WGM, gsz = (nM - fm) < WGM ? (nM - fm) : WGM;
        u.pm = fm + ((wgid % nig) % gsz); u.pn = (wgid % nig) / gsz; return true;
    }
};

__device__ __forceinline__ unsigned cvt_pk_bf16(float lo, float hi) { unsigned r; asm volatile("v_cvt_pk_bf16_f32 %0, %1, %2" : "=v"(r) : "v"(lo), "v"(hi)); return r; }

struct OpsPlain {
    static constexpr bool GATHER = false;
    const char* A; const char* Bt; int K, lda; size_t a_pn;
    __device__ __forceinline__ const char* a_base(const Unit& u) const { return A + (size_t)u.pm * ((size_t)BM * lda * 2) + (size_t)u.pn * a_pn; }
    __device__ __forceinline__ const char* b_base(const Unit& u) const { return Bt + (size_t)u.pn * ((size_t)BM * K * 2); }
    __device__ __forceinline__ void a_off(const Unit&, const int (&R)[2], const int (&C)[2], unsigned (&o0)[2], unsigned (&o1)[2]) const {
#pragma unroll
        for (int i = 0; i < 2; ++i) { o0[i] = (unsigned)(R[i] * lda + C[i]) * 2u; o1[i] = o0[i]; } }
};
struct OpsMoe1 {
    static constexpr bool GATHER = true;
    const char* A; const char* Bt; int K, lda; const int* row_tok; const PG8_LAS int* pexp;
    __device__ __forceinline__ const char* a_base(const Unit&) const { return A; }
    __device__ __forceinline__ const char* b_base(const Unit& u) const { const int e = pexp[16 + u.pm]; return Bt + ((size_t)e * 1024 + (size_t)u.pn * BM) * ((size_t)K * 2); }
    __device__ __forceinline__ void a_off(const Unit& u, const int (&R)[2], const int (&C)[2], unsigned (&o0)[2], unsigned (&o1)[2]) const {
#pragma unroll
        for (int i = 0; i < 2; ++i) { const int t0 = row_tok[u.pm * BM + R[i]], t1 = row_tok[u.pm * BM + HALF + R[i]];
            o0[i] = (unsigned)(t0 * lda + C[i]) * 2u; o1[i] = (unsigned)(t1 * lda + C[i]) * 2u; } }
};
struct OpsMoe2 {
    static constexpr bool GATHER = false;
    const char* A; const char* Bt; int K, lda; const PG8_LAS int* pexp;
    __device__ __forceinline__ const char* a_base(const Unit& u) const { return A + (size_t)u.pm * ((size_t)BM * lda * 2); }
    __device__ __forceinline__ const char* b_base(const Unit& u) const { const int e = pexp[16 + u.pm]; return Bt + ((size_t)e * 1024 + (size_t)u.pn * BM) * ((size_t)K * 2); }
    __device__ __forceinline__ void a_off(const Unit&, const int (&R)[2], const int (&C)[2], unsigned (&o0)[2], unsigned (&o1)[2]) const {
#pragma unroll
        for (int i = 0; i < 2; ++i) { o0[i] = (unsigned)(R[i] * lda + C[i]) * 2u; o1[i] = o0[i]; } }
};

#define EPI_LOOP_AI_M for (int ai = 0; ai < 2; ++ai) _Pragma("unroll") for (int m = 0; m < 4; ++m)
__device__ __forceinline__ u32x4 pack8(const f32x4& v0, const f32x4& v1) { u32x4 w; w.x = cvt_pk_bf16(v0[0], v0[1]); w.y = cvt_pk_bf16(v0[2], v0[3]); w.z = cvt_pk_bf16(v1[0], v1[1]); w.w = cvt_pk_bf16(v1[2], v1[3]); return w; }
__device__ __forceinline__ void unpack8(const u32x4& w, f32x4& v0, f32x4& v1) { v0 = (f32x4){bflo(w.x), bfhi(w.x), bflo(w.y), bfhi(w.y)}; v1 = (f32x4){bflo(w.z), bfhi(w.z), bflo(w.w), bfhi(w.w)}; }

struct EpiProj {
    bf16_t* PB;
    __device__ __forceinline__ void operator()(const f32x4 (&acc)[2][2][4][2], const Unit& u, int wr, int wc, int fr, int fq) const {
        const int row0 = u.pm * BM + wr * 64 + fr, col0 = u.pn * BM + wc * 32 + 8 * fq; const bool sig = u.pn >= 5;
#pragma unroll
        EPI_LOOP_AI_M { bf16_t* rowp = PB + (size_t)(row0 + ai * HALF + m * 16) * PBW + col0;
#pragma unroll
            for (int bj = 0; bj < 2; ++bj) { f32x4 v0 = acc[ai][bj][m][0], v1 = acc[ai][bj][m][1];
                if (sig) {
#pragma unroll
                    for (int j = 0; j < 4; ++j) { v0[j] = fast_sigmoid(v0[j]); v1[j] = fast_sigmoid(v1[j]); } }
                *(u32x4*)(rowp + bj * HALF) = pack8(v0, v1); } }
    }
};
struct EpiPool {
    bf16_t* TP; const bf16_t* PB; const float* pscale;
    __device__ __forceinline__ void operator()(const f32x4 (&acc)[2][2][4][2], const Unit& u, int wr, int wc, int fr, int fq) const {
        const int row0 = u.pm * BM + wr * 64 + fr, col0 = u.pn * BM + wc * 32 + 8 * fq;
        f32x4 ps[2][2];
#pragma unroll
        for (int bj = 0; bj < 2; ++bj)
#pragma unroll
            for (int n = 0; n < 2; ++n) ps[bj][n] = *(const f32x4*)(pscale + col0 + bj * HALF + 4 * n);
#pragma unroll
        EPI_LOOP_AI_M { const size_t row = (size_t)(row0 + ai * HALF + m * 16);
#pragma unroll
            for (int bj = 0; bj < 2; ++bj) { const u32x4 gw = *(const u32x4*)(PB + row * PBW + C_G0 + col0 + bj * HALF); f32x4 g0, g1; unpack8(gw, g0, g1);
                const f32x4 v0 = acc[ai][bj][m][0] * ps[bj][0] * g0, v1 = acc[ai][bj][m][1] * ps[bj][1] * g1;
                *(u32x4*)(TP + row * D + col0 + bj * HALF) = pack8(v0, v1); } }
    }
};
struct EpiQ {
    bf16_t* Q; const float* rq; const float* rope;
    __device__ __forceinline__ void operator()(const f32x4 (&acc)[2][2][4][2], const Unit& u, int wr, int wc, int fr, int fq) const {
        const int row0 = u.pm * BM + wr * 64 + fr;
#pragma unroll
        EPI_LOOP_AI_M { const int row = row0 + ai * HALF + m * 16; const float sc = rq[row] * QSCALE; const int pos = row & (SEQ - 1);
#pragma unroll
            for (int bj = 0; bj < 2; ++bj) { f32x4 v0 = acc[ai][bj][m][0] * sc, v1 = acc[ai][bj][m][1] * sc; const int cc = bj * HALF + wc * 32 + 8 * fq;
                if (u.pn < 2) { const int col = u.pn * BM + cc, h = col >> 6, d = col & 63;
                    *(u32x4*)(Q + (size_t)row * QP + h * QKD + d) = pack8(v0, v1); }
                else { const int h = cc >> 5, i2 = cc & 31; const float* rt = rope + ((size_t)pos * 16 + (i2 >> 1)) * 2;
                    const f32x4 c0 = *(const f32x4*)rt, c1 = *(const f32x4*)(rt + 4);
                    const f32x4 o0 = (f32x4){v0[0] * c0[0] - v0[1] * c0[1], v0[0] * c0[1] + v0[1] * c0[0], v0[2] * c0[2] - v0[3] * c0[3], v0[2] * c0[3] + v0[3] * c0[2]};
                    const f32x4 o1 = (f32x4){v1[0] * c1[0] - v1[1] * c1[1], v1[0] * c1[1] + v1[1] * c1[0], v1[2] * c1[2] - v1[3] * c1[3], v1[2] * c1[3] + v1[3] * c1[2]};
                    *(u32x4*)(Q + (size_t)row * QP + h * QKD + 64 + i2) = pack8(o0, o1); } } }
    }
};
struct EpiKV {
    bf16_t* Kf; bf16_t* V; const float* rkv;
    __device__ __forceinline__ void operator()(const f32x4 (&acc)[2][2][4][2], const Unit& u, int wr, int wc, int fr, int fq) const {
        const int row0 = u.pm * BM + wr * 64 + fr;
#pragma unroll
        EPI_LOOP_AI_M { const int row = row0 + ai * HALF + m * 16; const float sc = rkv[row];
#pragma unroll
            for (int bj = 0; bj < 2; ++bj) { const f32x4 v0 = acc[ai][bj][m][0] * sc, v1 = acc[ai][bj][m][1] * sc; const int col = (u.pn & 1) * BM + bj * HALF + wc * 32 + 8 * fq;
                if (u.pn < 2) { const int h = col >> 6, d = col & 63; *(u32x4*)(Kf + (size_t)row * QP + h * QKD + d) = pack8(v0, v1); }
                else *(u32x4*)(V + (size_t)row * 512 + col) = pack8(v0, v1); } }
    }
};
struct EpiMla {
    bf16_t* TP; const bf16_t* PB;
    __device__ __forceinline__ void operator()(const f32x4 (&acc)[2][2][4][2], const Unit& u, int wr, int wc, int fr, int fq) const {
        const int row0 = u.pm * BM + wr * 64 + fr, col0 = u.pn * BM + wc * 32 + 8 * fq;
#pragma unroll
        EPI_LOOP_AI_M { const size_t row = (size_t)(row0 + ai * HALF + m * 16);
#pragma unroll
            for (int bj = 0; bj < 2; ++bj) { const u32x4 gw = *(const u32x4*)(PB + row * PBW + C_G1 + col0 + bj * HALF); const u32x4 tw = *(const u32x4*)(TP + row * D + col0 + bj * HALF);
                f32x4 g0, g1, t0, t1; unpack8(gw, g0, g1); unpack8(tw, t0, t1);
                const f32x4 v0 = t0 + acc[ai][bj][m][0] * g0, v1 = t1 + acc[ai][bj][m][1] * g1;
                *(u32x4*)(TP + row * D + col0 + bj * HALF) = pack8(v0, v1); } }
    }
};
struct EpiOut {
    bf16_t* VH; const float* x; float* stats;
    __device__ __forceinline__ void operator()(const f32x4 (&acc)[2][2][4][2], const Unit& u, int wr, int wc, int fr, int fq) const {
        const int row0 = u.pm * BM + wr * 64 + fr, col0 = u.pn * BM + wc * 32 + 8 * fq;
#pragma unroll
        EPI_LOOP_AI_M { const size_t row = (size_t)(row0 + ai * HALF + m * 16); float s = 0.f, q = 0.f;
#pragma unroll
            for (int bj = 0; bj < 2; ++bj) { const float* xp = x + row * D + col0 + bj * HALF; const f32x4 x0 = *(const f32x4*)xp, x1 = *(const f32x4*)(xp + 4);
                const f32x4 v0 = x0 * ALPHA + acc[ai][bj][m][0], v1 = x1 * ALPHA + acc[ai][bj][m][1];
                s += (v0[0] + v0[1]) + (v0[2] + v0[3]) + (v1[0] + v1[1]) + (v1[2] + v1[3]);
                q += (v0[0] * v0[0] + v0[1] * v0[1]) + (v0[2] * v0[2] + v0[3] * v0[3]) + (v1[0] * v1[0] + v1[1] * v1[1]) + (v1[2] * v1[2] + v1[3] * v1[3]);
                *(u32x4*)(VH + row * D + col0 + bj * HALF) = pack8(v0, v1); }
            s += __shfl_xor(s, 16); s += __shfl_xor(s, 32); q += __shfl_xor(q, 16); q += __shfl_xor(q, 32);
            if (fq == 0) *(f32x2*)(stats + row * 32 + (u.pn * 4 + wc) * 2) = (f32x2){s, q}; }
    }
};
struct EpiHid {
    bf16_t* HID;
    __device__ __forceinline__ void operator()(const f32x4 (&acc)[2][2][4][2], const Unit& u, int wr, int wc, int fr, int fq) const {
        const int row0 = u.pm * BM + wr * 64 + fr, col0 = u.pn * HALF + wc * 32 + 8 * fq;
#pragma unroll
        EPI_LOOP_AI_M { const size_t row = (size_t)(row0 + ai * HALF + m * 16); f32x4 v0, v1;
#pragma unroll
            for (int j = 0; j < 4; ++j) { const float g0 = acc[ai][0][m][0][j], g1 = acc[ai][0][m][1][j];
                v0[j] = g0 * fast_sigmoid(g0) * acc[ai][1][m][0][j]; v1[j] = g1 * fast_sigmoid(g1) * acc[ai][1][m][1][j]; }
            *(u32x4*)(HID + row * DEXP + col0) = pack8(v0, v1); }
    }
};
struct EpiDown {
    bf16_t* Y; const float* roww;
    __device__ __forceinline__ void operator()(const f32x4 (&acc)[2][2][4][2], const Unit& u, int wr, int wc, int fr, int fq) const {
        const int row0 = u.pm * BM + wr * 64 + fr, col0 = u.pn * BM + wc * 32 + 8 * fq;
#pragma unroll
        EPI_LOOP_AI_M { const size_t row = (size_t)(row0 + ai * HALF + m * 16); const float w = roww[row];
#pragma unroll
            for (int bj = 0; bj < 2; ++bj) *(u32x4*)(Y + row * D + col0 + bj * HALF) = pack8(acc[ai][bj][m][0] * w, acc[ai][bj][m][1] * w); }
    }
};

template <class Epi, class Sched, class Ops, bool ALIGN_EPI>
__device__ __forceinline__ void gemm_phase(PG8_LAS unsigned char* lds, const Ops& G, const Sched& S, const Epi& E) {
    const int tid = opaque_tid(), wid = __builtin_amdgcn_readfirstlane(tid >> 6), lane = tid & 63, wr = wid >> 2, wc = wid & 3, fr = lane & 15, fq = lane >> 4;
    const int K = G.K, nt = K / BK;
    unsigned voffB[2]; int Rr[2], Cc[2];
#pragma unroll
    for (int i = 0; i < 2; ++i) { int R, C; stage_rc(tid * 16 + i * 8192, R, C); const int Rb = (R & ~31) + perm32(R & 31); Rr[i] = R; Cc[i] = C; voffB[i] = (unsigned)(Rb * K + C) * 2u; }
    const size_t kstep = (size_t)(BK * 2);
    const size_t hstepB = (size_t)HALF * K * 2;
    const unsigned ldsw = (unsigned)wid * 1024u;
    const int aoff = lds_byte(wr * 64 + fr, fq * 8), boff = lds_byte(wc * 32 + fr, fq * 8);
#define PG8_SA(b, h) (((b) * 2 + (h)) * HTB)
#define PG8_SB(b, h) ((4 + (b) * 2 + (h)) * HTB)
#define PG8_STAGE(bufoff, gbase, voff) do { _Pragma("unroll") for (int _i = 0; _i < 2; ++_i) \
        __builtin_amdgcn_global_load_lds((const unsigned*)((const char*)(gbase) + (voff)[_i]), (PG8_LAS unsigned*)(lds + (bufoff) + ldsw + _i * 8192), 16, 0, 0); } while (0)
#define PG8_LDA(dst, b, h) do { _Pragma("unroll") for (int m = 0; m < 4; ++m) _Pragma("unroll") for (int k = 0; k < 2; ++k) dst[m][k] = *(const PG8_LAS bf16x8*)(lds + PG8_SA(b, h) + aoff + m * 2048 + k * 1024); } while (0)
#define PG8_LDB(dst, b, h) do { _Pragma("unroll") for (int n = 0; n < 2; ++n) _Pragma("unroll") for (int k = 0; k < 2; ++k) dst[n][k] = *(const PG8_LAS bf16x8*)(lds + PG8_SB(b, h) + boff + n * 2048 + k * 1024); } while (0)
#define PG8_MMA(ai, bj, At, Bt) do { __builtin_amdgcn_s_setprio(1); _Pragma("unroll") for (int m = 0; m < 4; ++m) _Pragma("unroll") for (int n = 0; n < 2; ++n) _Pragma("unroll") for (int k = 0; k < 2; ++k) \
        acc[ai][bj][m][n] = __builtin_amdgcn_mfma_f32_16x16x32_bf16(Bt[n][k], At[m][k], acc[ai][bj][m][n], 0, 0, 0); __builtin_amdgcn_s_setprio(0); } while (0)
#define PG8_WAIT_V(n) asm volatile("s_waitcnt vmcnt(" #n ")" ::: "memory")
#define PG8_WAIT_L(n) asm volatile("s_waitcnt lgkmcnt(" #n ")" ::: "memory")
#define PG8_BAR __builtin_amdgcn_s_barrier()
#define PG8_SCHED __builtin_amdgcn_sched_barrier(0)
    Unit cur, nxt; int ui = 0;
    if (!S.next(0, cur)) return;
    f32x4 acc[2][2][4][2];
#pragma unroll
    for (int a = 0; a < 2; ++a)
#pragma unroll
        for (int b = 0; b < 2; ++b)
#pragma unroll
            for (int m = 0; m < 4; ++m)
#pragma unroll
                for (int n = 0; n < 2; ++n) acc[a][b][m][n] = (f32x4){0.f, 0.f, 0.f, 0.f};
    bf16x8 At[4][2], B0[2][2], B1[2][2];
    unsigned cA0[2], cA1[2], nA0[2], nA1[2];
    G.a_off(cur, Rr, Cc, cA0, cA1);
#pragma unroll
    for (int i = 0; i < 2; ++i) { nA0[i] = cA0[i]; nA1[i] = cA1[i]; }
    const size_t hstepA = Ops::GATHER ? 0 : (size_t)HALF * G.lda * 2;
#define PG8_A1(cur_) (Ops::GATHER ? (cur_##1) : (cur_##0))
    const char* cA = G.a_base(cur); const char* cB = G.b_base(cur);
    PG8_STAGE(PG8_SB(0, 0), cB, voffB); PG8_STAGE(PG8_SB(0, 1), cB + hstepB, voffB); PG8_STAGE(PG8_SA(0, 0), cA, cA0); PG8_STAGE(PG8_SA(0, 1), cA + hstepA, PG8_A1(cA));
    if (wr == 1) PG8_BAR;
    PG8_WAIT_V(2); PG8_BAR;
    PG8_STAGE(PG8_SB(1, 0), cB + kstep, voffB); PG8_STAGE(PG8_SA(1, 0), cA + kstep, cA0); PG8_STAGE(PG8_SB(1, 1), cB + hstepB + kstep, voffB);
    PG8_WAIT_V(6); PG8_BAR;
    for (;;) {
        const bool has_next = S.next(ui + 1, nxt);
        const char* nA = has_next ? G.a_base(nxt) : cA; const char* nB = has_next ? G.b_base(nxt) : cB;
        for (int t = 0; t < nt; t += 2) {
            const bool last = (t == nt - 2);
            const char* a1 = cA + (size_t)(t + 1) * kstep;
            const char* a2 = last ? nA : cA + (size_t)(t + 2) * kstep; const char* b2 = last ? nB : cB + (size_t)(t + 2) * kstep;
            const char* a3 = a2 + kstep; const char* b3 = b2 + kstep;
            unsigned xA0[2], xA1[2];
            if constexpr (Ops::GATHER) { if (last && has_next) G.a_off(nxt, Rr, Cc, nA0, nA1);
#pragma unroll
                for (int i = 0; i < 2; ++i) { xA0[i] = last ? nA0[i] : cA0[i]; xA1[i] = last ? nA1[i] : cA1[i]; } }
            else {
#pragma unroll
                for (int i = 0; i < 2; ++i) { xA0[i] = cA0[i]; xA1[i] = cA0[i]; } }
            PG8_LDB(B0, 0, 0); PG8_LDB(B1, 0, 1); PG8_SCHED; PG8_LDA(At, 0, 0); PG8_STAGE(PG8_SA(1, 1), a1 + hstepA, PG8_A1(cA));
            PG8_WAIT_V(8); PG8_WAIT_L(0); PG8_BAR; PG8_MMA(0, 0, At, B0); PG8_MMA(0, 1, At, B1); PG8_BAR; PG8_SCHED;
            PG8_LDA(At, 0, 1); PG8_STAGE(PG8_SB(0, 0), b2, voffB); PG8_STAGE(PG8_SB(0, 1), b2 + hstepB, voffB); PG8_STAGE(PG8_SA(0, 0), a2, xA0);
            PG8_WAIT_V(8); PG8_WAIT_L(0); PG8_BAR; PG8_MMA(1, 0, At, B0); PG8_MMA(1, 1, At, B1); PG8_BAR; PG8_SCHED;
            PG8_LDB(B0, 1, 0); PG8_LDB(B1, 1, 1); PG8_SCHED; PG8_LDA(At, 1, 0); PG8_STAGE(PG8_SA(0, 1), a2 + hstepA, xA1);
            PG8_WAIT_V(8); PG8_WAIT_L(0); PG8_BAR; PG8_MMA(0, 0, At, B0); PG8_MMA(0, 1, At, B1); PG8_BAR; PG8_SCHED;
            PG8_LDA(At, 1, 1); PG8_STAGE(PG8_SB(1, 0), b3, voffB); PG8_STAGE(PG8_SB(1, 1), b3 + hstepB, voffB); PG8_STAGE(PG8_SA(1, 0), a3, xA0);
            PG8_WAIT_V(8); PG8_WAIT_L(0); PG8_BAR; PG8_MMA(1, 0, At, B0); PG8_MMA(1, 1, At, B1); PG8_BAR; PG8_SCHED;
        }
        if constexpr (ALIGN_EPI) { if (wr == 0) PG8_BAR; }
        E(acc, cur, wr, wc, fr, fq);
        if (!has_next) break;
#pragma unroll
        for (int a = 0; a < 2; ++a)
#pragma unroll
            for (int b = 0; b < 2; ++b)
#pragma unroll
                for (int m = 0; m < 4; ++m)
#pragma unroll
                    for (int n = 0; n < 2; ++n) acc[a][b][m][n] = (f32x4){0.f, 0.f, 0.f, 0.f};
        cur = nxt; cA = nA; cB = nB; ++ui;
#pragma unroll
        for (int i = 0; i < 2; ++i) { cA0[i] = nA0[i]; cA1[i] = nA1[i]; }
        if constexpr (ALIGN_EPI) { if (wr == 1) PG8_BAR; }
    }
    PG8_WAIT_V(0);
    if constexpr (!ALIGN_EPI) { if (wr == 0) PG8_BAR; }
    PG8_BAR;
#undef PG8_SA
#undef PG8_A1
#undef PG8_SB
#undef PG8_STAGE
#undef PG8_LDA
#undef PG8_LDB
#undef PG8_MMA
#undef PG8_WAIT_V
#undef PG8_WAIT_L
#undef PG8_BAR
#undef PG8_SCHED
}
}

namespace attn {
constexpr int KBUF = 12288, VBUF = 8192;
constexpr int NBUF = 3;
constexpr int LDS_K = 0, LDS_V = NBUF * KBUF, LDS_WS = LDS_V + NBUF * VBUF, LDS_OST = LDS_WS + 8 * 256, LDS_BYTES = LDS_OST + 8 * 4096;
typedef LAS const char* lds_cptr;
__device__ __forceinline__ int crow(int r, int hi) { return (r & 3) + 8 * (r >> 2) + 4 * hi; }
__device__ __forceinline__ float max3f(float a, float b, float c) { return __builtin_fmaxf(__builtin_fmaxf(a, b), c); }
__device__ __forceinline__ float rowmax(const f32x16& p0, const f32x16& p1) {
    float a = max3f(p0[0], p0[1], p1[0]), b = max3f(p0[2], p0[3], p1[1]); a = max3f(a, p1[2], p1[3]);
#pragma unroll
    for (int r = 4; r < 16; r += 4) { a = max3f(a, p0[r], p0[r + 1]); b = max3f(b, p0[r + 2], p0[r + 3]); a = max3f(a, p1[r], p1[r + 1]); b = max3f(b, p1[r + 2], p1[r + 3]); }
    const float m = __builtin_fmaxf(a, b);
    auto rr = __builtin_amdgcn_permlane32_swap(__float_as_uint(m), __float_as_uint(m), false, false);
    return __builtin_fmaxf(__uint_as_float(rr[0]), __uint_as_float(rr[1]));
}
__device__ __forceinline__ unsigned cvtpk(float lo, float hi) { unsigned r; asm volatile("v_cvt_pk_bf16_f32 %0, %1, %2" : "=v"(r) : "v"(lo), "v"(hi)); return r; }

template <int THRL> __device__ __forceinline__ void attn_unit(int b, int h, int qb, const bf16* Q, const bf16* __restrict__ K, const bf16* __restrict__ V, bf16* O, LAS unsigned char* shm) {
    const int tid = opaque_tid(), lane = tid & 63, r32 = lane & 31, hi = lane >> 5; const int wid = __builtin_amdgcn_readfirstlane(tid >> 6);
    const size_t rowbase = (size_t)b * SEQ; const int q0 = qb * 256;
    const bf16* Qw = Q + (rowbase + q0 + wid * 32) * QP + h * QKD;
    const bf16* Kh = K + rowbase * QP + h * QKD; const bf16* Vh = V + rowbase * 512 + h * VD;
    LAS float* wsf = (LAS float*)(shm + LDS_WS) + wid * 64;
    const int NT = 4 * qb + 4, my_nt = 4 * qb + (wid >> 1) + 1;
    const unsigned lds0 = (unsigned)(uintptr_t)shm;
#define ATT_GLDS(src, dstoff) do { unsigned keep_; asm volatile("s_mov_b32 %0, m0\n\ts_mov_b32 m0, %2\n\ts_nop 0\n\tglobal_load_lds_dwordx4 %1, off\n\ts_mov_b32 m0, %0" \
        : "=&s"(keep_) : "v"(src), "s"((unsigned)__builtin_amdgcn_readfirstlane(lds0 + (unsigned)(dstoff))) : "memory"); } while (0)
#define ATT_DMA(t, buf) do { const bf16* ks_ = Kh + (size_t)((t) * 64 + lane) * QP; \
        ATT_GLDS(ks_ + wid * 8, LDS_K + (buf) * KBUF + wid * 1024); \
        if (wid < 4) ATT_GLDS(ks_ + (wid + 8) * 8, LDS_K + (buf) * KBUF + (wid + 8) * 1024); \
        ATT_GLDS(Vh + (size_t)((t) * 64 + 16 * (wid & 3) + (lane >> 2)) * 512 + (wid >> 2) * 32 + (lane & 3) * 8, LDS_V + (buf) * VBUF + wid * 1024); } while (0)
    ATT_DMA(0, 0); ATT_DMA(1, 1);
    bf16x8 qr[6];
#pragma unroll
    for (int d0 = 0; d0 < 6; ++d0) qr[d0] = *reinterpret_cast<const bf16x8*>(&Qw[(size_t)r32 * QP + d0 * 16 + hi * 8]);
    asm volatile("" : "+v"(qr[0]), "+v"(qr[1]), "+v"(qr[2]), "+v"(qr[3]), "+v"(qr[4]), "+v"(qr[5]));
    float mhat = 0.f, l_reg = 0.f; f32x16 o[2]; o[0] = f32x16{}; o[1] = f32x16{};
    f32x16 negm = f32x16{}; asm volatile("" : "+v"(negm));
    const int vboff = ((lane >> 4) & 1) * 32 + (lane & 3) * 8 + (4 * hi + ((lane & 15) >> 2)) * 64;
    int buf = 0, buf2 = 2;
    for (int t = 0; t < NT; ++t) {
        if (t + 1 < NT) { if (wid < 4) asm volatile("s_waitcnt vmcnt(3)" ::: "memory"); else asm volatile("s_waitcnt vmcnt(2)" ::: "memory"); }
        else asm volatile("s_waitcnt vmcnt(0)" ::: "memory");
        asm volatile("s_waitcnt lgkmcnt(0)" ::: "memory");
        __builtin_amdgcn_s_barrier();
        asm volatile("" ::: "memory");
        if (t + 2 < NT) ATT_DMA(t + 2, buf2);
        if (t < my_nt) {
            f32x16 p0, p1;
            { lds_cptr kb = (lds_cptr)(shm + LDS_K + buf * KBUF) + hi * 1024 + r32 * 16;
              bf16x8 kf[12];
#pragma unroll
              for (int d0 = 0; d0 < 6; ++d0) { kf[2 * d0] = *(const LAS bf16x8*)(kb + d0 * 2048); kf[2 * d0 + 1] = *(const LAS bf16x8*)(kb + d0 * 2048 + 512); }
              __builtin_amdgcn_sched_barrier(0);
              p0 = __builtin_amdgcn_mfma_f32_32x32x16_bf16(kf[0], qr[0], negm, 0, 0, 0); p1 = __builtin_amdgcn_mfma_f32_32x32x16_bf16(kf[1], qr[0], negm, 0, 0, 0);
#pragma unroll
              for (int d0 = 1; d0 < 6; ++d0) { p0 = __builtin_amdgcn_mfma_f32_32x32x16_bf16(kf[2 * d0], qr[d0], p0, 0, 0, 0); p1 = __builtin_amdgcn_mfma_f32_32x32x16_bf16(kf[2 * d0 + 1], qr[d0], p1, 0, 0, 0); }
              __builtin_amdgcn_sched_barrier(0); }
            s16x4 vlo[8], vhh[8];
            { const int vb = (int)(uintptr_t)(shm + LDS_V + buf * VBUF) + vboff;
#pragma unroll
              for (int i = 0; i < 8; ++i) {
                  asm volatile("ds_read_b64_tr_b16 %0,%1 offset:%c2" : "=&v"(vlo[i]) : "v"(vb), "i"((i >> 2) * 4096 + (i & 3) * 1024) : "memory");
                  asm volatile("ds_read_b64_tr_b16 %0,%1 offset:%c2" : "=&v"(vhh[i]) : "v"(vb), "i"((i >> 2) * 4096 + (i & 3) * 1024 + 512) : "memory"); }
              __builtin_amdgcn_sched_barrier(0); }
            const float rm = rowmax(p0, p1);
            if (t == 0 || __any(rm > (float)THRL)) {
                const float dl = (t == 0) ? rm : __builtin_fmaxf(rm, 0.f); const float f = (t == 0) ? 0.f : __builtin_amdgcn_exp2f(-dl);
                mhat += dl; l_reg *= f;
#pragma unroll
                for (int r = 0; r < 16; ++r) { p0[r] -= dl; p1[r] -= dl; negm[r] = -mhat; }
                asm volatile("" : "+v"(negm));
                if (hi == 0) wsf[r32] = f;
                asm volatile("s_waitcnt lgkmcnt(0)" ::: "memory");
#pragma unroll
                for (int d_ = 0; d_ < 2; ++d_)
#pragma unroll
                    for (int r = 0; r < 16; ++r) o[d_][r] *= wsf[crow(r, hi)];
            }
            float sacc = 0.f;
#pragma unroll
            for (int r = 0; r < 16; ++r) { p0[r] = __builtin_amdgcn_exp2f(p0[r]); p1[r] = __builtin_amdgcn_exp2f(p1[r]); }
#pragma unroll
            for (int r = 0; r < 16; r += 2) { sacc += p0[r]; sacc += p0[r + 1]; sacc += p1[r]; sacc += p1[r + 1]; asm volatile("" : "+v"(sacc)); }
            l_reg += sacc;
            v4u pw0, pw1, pw2, pw3;
            pw0 = (v4u){cvtpk(p0[0], p0[1]), cvtpk(p0[2], p0[3]), cvtpk(p0[4], p0[5]), cvtpk(p0[6], p0[7])};
            pw1 = (v4u){cvtpk(p0[8], p0[9]), cvtpk(p0[10], p0[11]), cvtpk(p0[12], p0[13]), cvtpk(p0[14], p0[15])};
            pw2 = (v4u){cvtpk(p1[0], p1[1]), cvtpk(p1[2], p1[3]), cvtpk(p1[4], p1[5]), cvtpk(p1[6], p1[7])};
            pw3 = (v4u){cvtpk(p1[8], p1[9]), cvtpk(p1[10], p1[11]), cvtpk(p1[12], p1[13]), cvtpk(p1[14], p1[15])};
            asm volatile("s_waitcnt lgkmcnt(0)" ::: "memory"); __builtin_amdgcn_sched_barrier(0);
#define ATT_VF(i) (bf16x8){vlo[i][0], vlo[i][1], vlo[i][2], vlo[i][3], vhh[i][0], vhh[i][1], vhh[i][2], vhh[i][3]}
            o[0] = __builtin_amdgcn_mfma_f32_32x32x16_bf16(__builtin_bit_cast(bf16x8, pw0), ATT_VF(0), o[0], 0, 0, 0);
            o[1] = __builtin_amdgcn_mfma_f32_32x32x16_bf16(__builtin_bit_cast(bf16x8, pw0), ATT_VF(4), o[1], 0, 0, 0);
            o[0] = __builtin_amdgcn_mfma_f32_32x32x16_bf16(__builtin_bit_cast(bf16x8, pw1), ATT_VF(1), o[0], 0, 0, 0);
            o[1] = __builtin_amdgcn_mfma_f32_32x32x16_bf16(__builtin_bit_cast(bf16x8, pw1), ATT_VF(5), o[1], 0, 0, 0);
            o[0] = __builtin_amdgcn_mfma_f32_32x32x16_bf16(__builtin_bit_cast(bf16x8, pw2), ATT_VF(2), o[0], 0, 0, 0);
            o[1] = __builtin_amdgcn_mfma_f32_32x32x16_bf16(__builtin_bit_cast(bf16x8, pw2), ATT_VF(6), o[1], 0, 0, 0);
            o[0] = __builtin_amdgcn_mfma_f32_32x32x16_bf16(__builtin_bit_cast(bf16x8, pw3), ATT_VF(3), o[0], 0, 0, 0);
            o[1] = __builtin_amdgcn_mfma_f32_32x32x16_bf16(__builtin_bit_cast(bf16x8, pw3), ATT_VF(7), o[1], 0, 0, 0);
#undef ATT_VF
        }
        buf = (buf == NBUF - 1) ? 0 : buf + 1; buf2 = (buf2 == NBUF - 1) ? 0 : buf2 + 1;
    }
    { auto rr = __builtin_amdgcn_permlane32_swap(__float_as_uint(l_reg), __float_as_uint(l_reg), false, false); l_reg = __uint_as_float(rr[0]) + __uint_as_float(rr[1]); }
    if (hi == 0) wsf[32 + r32] = l_reg;
    asm volatile("s_waitcnt lgkmcnt(0)" ::: "memory");
    float rli[16];
#pragma unroll
    for (int r = 0; r < 16; ++r) rli[r] = __builtin_amdgcn_rcpf(wsf[32 + crow(r, hi)]);
    bf16* Ow = O + (rowbase + q0 + wid * 32) * 512 + h * VD;
    { LAS bf16* stg = (LAS bf16*)(shm + LDS_OST) + wid * 2048;
#pragma unroll
      for (int r = 0; r < 16; ++r) { const int orow = crow(r, hi);
#pragma unroll
          for (int d0 = 0; d0 < 2; ++d0) stg[orow * 64 + d0 * 32 + r32] = (bf16)f2bf(o[d0][r] * rli[r]); }
      asm volatile("s_waitcnt lgkmcnt(0)" ::: "memory");
#pragma unroll
      for (int i = 0; i < 4; ++i) { const int row = i * 8 + (lane >> 3), ch = lane & 7; const v4u v = *(const LAS v4u*)(stg + row * 64 + ch * 8); *(v4u*)(Ow + (size_t)row * 512 + ch * 8) = v; } }
    asm volatile("s_waitcnt lgkmcnt(0)" ::: "memory");
    __builtin_amdgcn_s_barrier();
    asm volatile("" ::: "memory");
#undef ATT_GLDS
#undef ATT_DMA
}
}

#define XB_TMO      128
#define XB_XCNT(j)  (256  + 64 * (j))
#define XB_XSUB(j)  (1280 + 64 * (j))
#define XB_XGEN(j)  (2304 + 64 * (j))
#define XB_TOP      3328
#define XB_TOPGEN   3392
#define XCD_BAR_WORDS 3456
#define XB_SPIN_CAP (1u << 22)

__device__ __forceinline__ unsigned xb_ld(unsigned* p)              { return __hip_atomic_load(p, __ATOMIC_RELAXED, __HIP_MEMORY_SCOPE_AGENT); }
__device__ __forceinline__ unsigned xb_add(unsigned* p, unsigned v) { return __hip_atomic_fetch_add(p, v, __ATOMIC_RELAXED, __HIP_MEMORY_SCOPE_AGENT); }
__device__ __forceinline__ unsigned xb_xcc_id() { return (unsigned)__builtin_amdgcn_s_getreg((3 << 11) | 20) & 0xFu; }
#define XB_SPIN(cond, bar) do { unsigned _sp = 0; while (cond) { __builtin_amdgcn_s_sleep(1); \
    if ((++_sp & 255u) == 0u) { if (xb_ld(&(bar)[XB_TMO])) break; if (_sp > XB_SPIN_CAP) { atomicAdd(&(bar)[XB_TMO], 1u); break; } } } } while (0)

struct XcdBarrier { unsigned* bar; unsigned x; volatile LAS unsigned* st; };
__device__ __forceinline__ XcdBarrier xcd_barrier_post(unsigned* bar, volatile LAS unsigned* st) {
    XcdBarrier b; b.bar = bar; b.x = xb_xcc_id(); b.st = st;
    if (threadIdx.x == 0) (void)xb_add(&bar[XB_XCNT(b.x)], 1u);
    return b;
}
__device__ __forceinline__ void xcd_barrier_complete(unsigned* bar, unsigned x, unsigned& nloc, unsigned& nx) {
    const unsigned G = gridDim.x * gridDim.y * gridDim.z;
    unsigned sum, cnt, mine, sp = 0u;
    for (;;) {
        sum = 0u; cnt = 0u; mine = 0u;
#pragma unroll
        for (unsigned j = 0; j < 16; ++j) { const unsigned c = xb_ld(&bar[XB_XCNT(j)]); sum += c; cnt += (c > 0u) ? 1u : 0u; mine = (j == x) ? c : mine; }
        if (sum == G) break;
        __builtin_amdgcn_s_sleep(1);
        if ((++sp & 255u) == 0u) { if (xb_ld(&bar[XB_TMO])) break; if (sp > XB_SPIN_CAP) { atomicAdd(&bar[XB_TMO], 1u); break; } }
    }
    nloc = mine > 0u ? mine : 1u; nx = cnt > 0u ? cnt : 1u;
}
__device__ __forceinline__ void xcd_barrier(const XcdBarrier& b) {
    asm volatile("s_waitcnt vmcnt(0)" ::: "memory");
    __syncthreads();
    if (threadIdx.x == 0) {
        unsigned* bar = b.bar;
        __builtin_amdgcn_s_waitcnt(0);
        unsigned nloc = b.st[0], nx = b.st[1];
        if (nloc == 0u) { xcd_barrier_complete(bar, b.x, nloc, nx); b.st[0] = nloc; b.st[1] = nx; }
        const unsigned old = xb_add(&bar[XB_XSUB(b.x)], 1u);
        const unsigned gen = old / nloc;
        if (old + 1u == (gen + 1u) * nloc) {
            __builtin_amdgcn_fence(__ATOMIC_RELEASE, "agent");
            asm volatile("s_waitcnt vmcnt(0)" ::: "memory");
            const unsigned og = xb_add(&bar[XB_TOP], 1u);
            const unsigned tg = og / nx;
            if (og + 1u == (tg + 1u) * nx) xb_add(&bar[XB_TOPGEN], 1u);
            else XB_SPIN(xb_ld(&bar[XB_TOPGEN]) == tg, bar);
            __builtin_amdgcn_fence(__ATOMIC_ACQUIRE, "agent");
            xb_add(&bar[XB_XGEN(b.x)], 1u);
            asm volatile("s_waitcnt vmcnt(0)" ::: "memory");
        } else {
            XB_SPIN(xb_ld(&bar[XB_XGEN(b.x)]) == gen, bar);
            __builtin_amdgcn_fence(__ATOMIC_ACQUIRE, "agent");
            asm volatile("s_waitcnt vmcnt(0)" ::: "memory");
        }
    }
    __syncthreads();
}

constexpr int NWAVES = 8;
struct Params {
    const float* in[21];
    float* out; unsigned char* ws;
    int ph_lo, ph_hi;
};
struct Frame {
    LAS unsigned char* lds; volatile LAS unsigned* MISC;
    int tid, lane, wave, vcu, G;
    unsigned char* ws; unsigned char* outb;
};

__device__ __forceinline__ void frame_ids(Frame& F) { F.tid = opaque_tid(); F.lane = F.tid & 63; F.wave = __builtin_amdgcn_readfirstlane(F.tid >> 6); }
__device__ __forceinline__ int il32(int j) { return j < 16 ? 2 * j : 2 * (j - 16) + 1; }
__device__ __forceinline__ int maprow(int kind, int n) {
    switch (kind) {
    case 1: return n < C_KPE ? n : (n < C_KPE + 32 ? C_KPE + il32(n - C_KPE) : n + 96);
    case 2: { const int h = n / 96, j = n - h * 96; return j < 64 ? h * 64 + j : 512 + h * 32 + il32(j - 64); }
    case 3: { const int h = n >> 7, j = n & 127; return j < 64 ? h * 64 + j : 512 + h * 64 + (j - 64); }
    case 4: return (n >> 7) * 256 + (n & 127);
    case 5: return (n >> 7) * 256 + 128 + (n & 127);
    default: return n; }
}
__device__ __forceinline__ void p0_transpose_item(const float* W, int K, int N, bf16* WT, const float* kscale, int kind, LAS float* scr, int item, int lane) {
    const int nblk = N / 32, kb = item / nblk, nb = item % nblk, k0 = 64 * kb, n0 = 32 * nb;
#pragma unroll 8
    for (int i = 0; i < 32; ++i) { const int kk = 2 * i + (lane >> 5); float v = W[(size_t)(k0 + kk) * N + n0 + (lane & 31)]; if (kscale) v *= kscale[k0 + kk]; scr[kk * 33 + (lane & 31)] = v; }
    LDS_WAIT(); asm volatile("" ::: "memory");
    const int c = lane & 7;
#pragma unroll
    for (int j = 0; j < 4; ++j) { const int n = (lane >> 3) + 8 * j; const LAS float* s = scr + (8 * c) * 33 + n;
        v4u o; o.x = pk2(s[0 * 33], s[1 * 33]); o.y = pk2(s[2 * 33], s[3 * 33]); o.z = pk2(s[4 * 33], s[5 * 33]); o.w = pk2(s[6 * 33], s[7 * 33]);
        *(GAS v4u*)(WT + (size_t)maprow(kind, n0 + n) * K + k0 + 8 * c) = o; }
    LDS_WAIT(); asm volatile("" ::: "memory");
}
__device__ __forceinline__ void p0_prologue(Frame& F, const Params& P) {
    LAS float* scr = (LAS float*)(F.lds + RING_OFF + F.wave * 16384);
    const int gw = F.vcu * NWAVES + F.wave, NGW = F.G * NWAVES;
    unsigned char* ws = F.ws;
    constexpr int I_IN = 16 * 101, I_POOL = 64, I_UQ = 6 * 24, I_UKV = 4 * 32, I_MLAO = 8 * 32, I_OUT = 16 * 32, I_GE = 16 * 16, I_G = 32 * I_GE, I_DE = 8 * 32, I_D = 32 * I_DE;
    constexpr int NITEMS = I_IN + I_POOL + I_UQ + I_UKV + I_MLAO + I_OUT + 2 * I_G + I_D;
    for (int it = gw; it < NITEMS; it += NGW) {
        int r = it;
        if (r < I_IN) { p0_transpose_item(P.in[1], 1024, 3232, (bf16*)(ws + W_IN_T), nullptr, 1, scr, r, F.lane); continue; } r -= I_IN;
        if (r < I_POOL) { const int g = r >> 4; p0_transpose_item(P.in[2] + (size_t)g * 128 * 256, 128, 256, (bf16*)(ws + W_POOL_T) + (size_t)g * 256 * 128, nullptr, 0, scr, r & 15, F.lane); continue; } r -= I_POOL;
        if (r < I_UQ) { p0_transpose_item(P.in[5], 384, 768, (bf16*)(ws + W_UQ_T), P.in[4], 2, scr, r, F.lane); continue; } r -= I_UQ;
        if (r < I_UKV) { p0_transpose_item(P.in[7], 256, 1024, (bf16*)(ws + W_UKV_T), P.in[6], 3, scr, r, F.lane); continue; } r -= I_UKV;
        if (r < I_MLAO) { p0_transpose_item(P.in[8], 512, 1024, (bf16*)(ws + W_MLAO_T), nullptr, 0, scr, r, F.lane); continue; } r -= I_MLAO;
        if (r < I_OUT) { p0_transpose_item(P.in[9], 1024, 1024, (bf16*)(ws + W_OUT_T), nullptr, 0, scr, r, F.lane); continue; } r -= I_OUT;
        if (r < I_G) { const int e = r / I_GE; p0_transpose_item(P.in[16] + (size_t)e * 1024 * 512, 1024, 512, (bf16*)(ws + W_GU_T) + (size_t)e * 1024 * 1024, nullptr, 4, scr, r % I_GE, F.lane); continue; } r -= I_G;
        if (r < I_G) { const int e = r / I_GE; p0_transpose_item(P.in[17] + (size_t)e * 1024 * 512, 1024, 512, (bf16*)(ws + W_GU_T) + (size_t)e * 1024 * 1024, nullptr, 5, scr, r % I_GE, F.lane); continue; } r -= I_G;
        { const int e = r / I_DE; p0_transpose_item(P.in[18] + (size_t)e * 512 * 1024, 512, 1024, (bf16*)(ws + W_DN_T) + (size_t)e * 1024 * 512, nullptr, 0, scr, r % I_DE, F.lane); }
    }
    const int gt = (F.vcu * NWAVES + F.wave) * 64 + F.lane, NGT = NGW * 64;
    for (int i = gt; i < 96 * 1024 / 8; i += NGT) *(GAS v4u*)((bf16*)(ws + W_IN_T) + (size_t)1184 * 1024 + (size_t)i * 8) = (v4u){0u, 0u, 0u, 0u};
    for (int i = gt; i < 48 * 1024; i += NGT) { const int c = i >> 10, k = i & 1023; float v = 0.f; if (c < 4) v = P.in[12][k * 4 + c]; else if (c < 36) v = P.in[14][k * 32 + (c - 4)];
        ((bf16*)(ws + W_ROUTER_T))[i] = (bf16)f2bf(v); }
    for (int i = gt; i < SEQ * 16; i += NGT) { const int pos = i >> 4, p = i & 15; const float inv = 1.0f / powf(10000.0f, (float)(2 * p) / 32.0f); const float ang = (float)pos * inv;
        const double rev = (double)ang * 0.15915494309189533577; const float fr = (float)(rev - floor(rev));
        ((f32x2*)(ws + SM_ROPE))[i] = (f32x2){__builtin_amdgcn_cosf(fr), __builtin_amdgcn_sinf(fr)}; }
    { const float* x = P.in[0]; bf16* xb = (bf16*)(ws + WS_XB);
      for (int i = gt; i < M * D / 8; i += NGT) { const f32x4 a = *(const GAS f32x4*)(x + (size_t)i * 8), b = *(const GAS f32x4*)(x + (size_t)i * 8 + 4);
          v4u o; o.x = pk2(a.x, a.y); o.y = pk2(a.z, a.w); o.z = pk2(b.x, b.y); o.w = pk2(b.z, b.w); *(GAS v4u*)(xb + (size_t)i * 8) = o; } }
}

__device__ __forceinline__ void unpack8f(const v4u& w, float (&f)[8]) { f[0] = bflo(w.x); f[1] = bfhi(w.x); f[2] = bflo(w.y); f[3] = bfhi(w.y); f[4] = bflo(w.z); f[5] = bfhi(w.z); f[6] = bflo(w.w); f[7] = bfhi(w.w); }
__device__ __forceinline__ void p2_thin(Frame& F) {
    const bf16* PB = (const bf16*)(F.ws + WS_PB); bf16* pooled = (bf16*)(F.ws + WS_POOLED); bf16* Kf = (bf16*)(F.ws + WS_K);
    float* rq = (float*)(F.ws + SM_RQ); float* rkv = (float*)(F.ws + SM_RKV); const f32x2* rope = (const f32x2*)(F.ws + SM_ROPE);
    const int l = F.lane;
    for (int blk = blockIdx.x; blk < M / 128; blk += F.G) {
        const int t0 = blk * 128 + F.wave * 16, pos0 = t0 & (SEQ - 1);
        { const int g = l >> 4, W = 2 << g; const bf16* up = PB + (size_t)t0 * PBW + 8 * l;
          float sum[8];
#pragma unroll
          for (int j = 0; j < 8; ++j) sum[j] = 0.f;
#pragma unroll
          for (int j = 1; j < 16; ++j) { if (j < W && pos0 - j >= 0) { const v4u w = *(const GAS v4u*)(up - (ptrdiff_t)j * PBW); float f[8]; unpack8f(w, f);
#pragma unroll
                  for (int e = 0; e < 8; ++e) sum[e] += f[e]; } }
#pragma unroll 4
          for (int i = 0; i < 16; ++i) { const v4u cw = *(const GAS v4u*)(up + (size_t)i * PBW); float cur[8]; unpack8f(cw, cur);
              const int pos = pos0 + i; const int cnt = (pos + 1 < W) ? pos + 1 : W; const float inv = 1.0f / (float)cnt; float o[8];
#pragma unroll
              for (int e = 0; e < 8; ++e) { sum[e] += cur[e]; o[e] = sum[e] * inv - cur[e]; }
              v4u ow; ow.x = pk2(o[0], o[1]); ow.y = pk2(o[2], o[3]); ow.z = pk2(o[4], o[5]); ow.w = pk2(o[6], o[7]);
              *(GAS v4u*)(pooled + (size_t)(t0 + i) * 512 + 8 * l) = ow;
              if (pos - W + 1 >= 0) { const v4u w = *(const GAS v4u*)(up + (ptrdiff_t)(i - W + 1) * PBW); float f[8]; unpack8f(w, f);
#pragma unroll
                  for (int e = 0; e < 8; ++e) sum[e] -= f[e]; } } }
#pragma unroll 4
        for (int i = 0; i < 16; ++i) { const int t = t0 + i; const bf16* row = PB + (size_t)t * PBW; float sq = 0.f, sk = 0.f;
            if (l < 48) { const v4u w = *(const GAS v4u*)(row + C_CQ + 8 * l); float f[8]; unpack8f(w, f);
#pragma unroll
                for (int e = 0; e < 8; ++e) sq += f[e] * f[e]; }
            if (l < 32) { const v4u w = *(const GAS v4u*)(row + C_CKV + 8 * l); float f[8]; unpack8f(w, f);
#pragma unroll
                for (int e = 0; e < 8; ++e) sk += f[e] * f[e]; }
            sq = wave_sum(sq); sk = wave_sum(sk);
            if (l == 0) { rq[t] = 1.0f / sqrtf(sq * (1.0f / 384.0f) + EPS); rkv[t] = 1.0f / sqrtf(sk * (1.0f / 256.0f) + EPS); }
            if (l < 16) { const unsigned w = *(const GAS unsigned*)(row + C_KPE + 2 * l); const float x1 = bflo(w), x2 = bfhi(w); const f32x2 cs = rope[(size_t)(t & (SEQ - 1)) * 16 + l];
                const unsigned ow = pk2(x1 * cs.x - x2 * cs.y, x1 * cs.y + x2 * cs.x);
#pragma unroll
                for (int h = 0; h < NH; ++h) *(GAS unsigned*)(Kf + (size_t)t * QP + h * QKD + 64 + 2 * l) = ow; } }
    }
}

__device__ __forceinline__ void p7_ln_router(Frame& F, const Params& P) {
    const bf16* VH = (const bf16*)(F.ws + WS_VH); bf16* H = (bf16*)(F.ws + WS_H); const float* stats = (const float*)(F.ws + SM_STATS); const bf16* RT = (const bf16*)(F.ws + W_ROUTER_T);
    v4u* recs = (v4u*)(F.ws + SM_RECS); int* blkcnt = (int*)(F.ws + SM_BLKCNT);
    const float* g1 = P.in[10]; const float* b1 = P.in[11]; const float* brg = P.in[13]; const float* bre = P.in[15];
    LAS float* lg = (LAS float*)(F.lds + F.wave * 3072); LAS unsigned* hist = (LAS unsigned*)(F.lds + 32768);
    const int l = F.lane, r = l & 15, q = l >> 4;
    LAS float* gb = (LAS float*)(F.lds + 40960);
    { const int i = F.tid; ((LAS f32x4*)gb)[i] = (i < 256) ? *(const GAS f32x4*)(g1 + 4 * i) : *(const GAS f32x4*)(b1 + 4 * (i - 256)); }
    for (int blk = blockIdx.x; blk < M / 128; blk += F.G) {
        if (F.tid < 32) hist[F.tid] = 0u;
        __syncthreads();
        const int t = blk * 128 + F.wave * 16 + r;
        const bf16* vrow = VH + (size_t)t * D; bf16* hrow = H + (size_t)t * D;
        float mean, rstd;
        { const float* st = stats + (size_t)t * 32 + q * 8; const f32x4 a = *(const GAS f32x4*)st, b = *(const GAS f32x4*)(st + 4);
          float s = (a.x + a.z) + (b.x + b.z), qq = (a.y + a.w) + (b.y + b.w);
          s += __shfl_xor(s, 16); s += __shfl_xor(s, 32); qq += __shfl_xor(qq, 16); qq += __shfl_xor(qq, 32);
          mean = s * (1.0f / 1024.0f); const float var = qq * (1.0f / 1024.0f) - mean * mean; rstd = 1.0f / sqrtf(var + EPS); }
        f32x4 acc[3]; acc[0] = (f32x4){0.f, 0.f, 0.f, 0.f}; acc[1] = acc[0]; acc[2] = acc[0];
#pragma unroll 1
        for (int ch = 0; ch < 4; ++ch) {
            v4u vw[8];
#pragma unroll
            for (int j = 0; j < 8; ++j) vw[j] = *(const GAS v4u*)(vrow + 256 * ch + 32 * j + 8 * q);
#pragma unroll
            for (int j = 0; j < 8; ++j) { const int c0 = 256 * ch + 32 * j + 8 * q;
                float f[8]; unpack8f(vw[j], f);
                const f32x4 ga = *(const LAS f32x4*)(gb + c0), gbv = *(const LAS f32x4*)(gb + c0 + 4), ba = *(const LAS f32x4*)(gb + 1024 + c0), bb = *(const LAS f32x4*)(gb + 1024 + c0 + 4);
                float hv[8];
#pragma unroll
                for (int e = 0; e < 4; ++e) { hv[e] = (f[e] - mean) * rstd * ga[e] + ba[e]; hv[4 + e] = (f[4 + e] - mean) * rstd * gbv[e] + bb[e]; }
                v4u hw; hw.x = pk2(hv[0], hv[1]); hw.y = pk2(hv[2], hv[3]); hw.z = pk2(hv[4], hv[5]); hw.w = pk2(hv[6], hv[7]);
                *(GAS v4u*)(hrow + c0) = hw;
                const bf16x8 af = __builtin_bit_cast(bf16x8, hw);
#pragma unroll
                for (int ct = 0; ct < 3; ++ct) { const bf16x8 bfr = *(const GAS bf16x8*)(RT + (size_t)(16 * ct + r) * D + c0); acc[ct] = __builtin_amdgcn_mfma_f32_16x16x32_bf16(af, bfr, acc[ct], 0, 0, 0); } }
        }
#pragma unroll
        for (int ct = 0; ct < 3; ++ct)
#pragma unroll
            for (int j = 0; j < 4; ++j) lg[(4 * q + j) * 48 + 16 * ct + r] = acc[ct][j];
        LDS_WAIT(); asm volatile("" ::: "memory");
        if (l < 16) { const LAS float* lp = lg + l * 48; const int tok = blk * 128 + F.wave * 16 + l;
            float gl[4];
#pragma unroll
            for (int j = 0; j < 4; ++j) gl[j] = lp[j] + brg[j];
            int gi = 0; float gm = gl[0];
#pragma unroll
            for (int j = 1; j < 4; ++j) if (gl[j] > gm) { gm = gl[j]; gi = j; }
            float gs = 0.f;
#pragma unroll
            for (int j = 0; j < 4; ++j) gs += __expf(gl[j] - gm);
            const float gw_ = 1.0f / gs;
            float el[8];
#pragma unroll
            for (int j = 0; j < 8; ++j) el[j] = lp[4 + 8 * gi + j] + bre[8 * gi + j];
            int i1 = 0; float m1 = el[0];
#pragma unroll
            for (int j = 1; j < 8; ++j) if (el[j] > m1) { m1 = el[j]; i1 = j; }
            int i2 = -1; float m2 = -3.0e38f;
#pragma unroll
            for (int j = 0; j < 8; ++j) if (j != i1 && el[j] > m2) { m2 = el[j]; i2 = j; }
            const float p2 = __expf(m2 - m1), den = 1.0f / (1.0f + p2);
            const float w1 = gw_ * den, w2 = gw_ * p2 * den; const int e1 = 8 * gi + i1, e2 = 8 * gi + i2;
            recs[tok] = (v4u){(unsigned)e1, (unsigned)e2, __float_as_uint(w1), __float_as_uint(w2)};
            atomicAdd((unsigned*)&hist[e1], 1u); atomicAdd((unsigned*)&hist[e2], 1u); }
        __syncthreads();
        if (F.tid < 32) blkcnt[blk * 32 + F.tid] = (int)hist[F.tid];
        __syncthreads();
    }
}

__device__ __forceinline__ void p8_scatter(Frame& F) {
    const v4u* recs = (const v4u*)(F.ws + SM_RECS); const int* blkcnt = (const int*)(F.ws + SM_BLKCNT);
    int* row_tok = (int*)(F.ws + SM_ROWTOK); float* row_w = (float*)(F.ws + SM_ROWW); int* rowof = (int*)(F.ws + SM_ROWOF); int* pinfo = (int*)(F.ws + SM_PINFO);
    LAS int* part_tot = (LAS int*)(F.lds);
    LAS int* part_pre = (LAS int*)(F.lds + 2048);
    LAS int* cnt = (LAS int*)(F.lds + 4096);
    LAS int* base = (LAS int*)(F.lds + 4224);
    LAS int* pstart = (LAS int*)(F.lds + 4352);
    LAS int* exps = (LAS int*)(F.lds + 4608);
    const int nblk = M / 128;
    for (int blk = blockIdx.x; blk < nblk; blk += F.G) {
        { const int e = F.tid & 31, part = F.tid >> 5; int tot = 0, pre = 0;
          for (int b = part * 16; b < part * 16 + 16; ++b) { const int c = blkcnt[b * 32 + e]; tot += c; if (b < blk) pre += c; }
          part_tot[part * 32 + e] = tot; part_pre[part * 32 + e] = pre; }
        __syncthreads();
        if (F.tid < 32) { int tot = 0, pre = 0;
#pragma unroll
            for (int p = 0; p < 16; ++p) { tot += part_tot[p * 32 + F.tid]; pre += part_pre[p * 32 + F.tid]; }
            cnt[F.tid] = tot; base[F.tid] = pre; }
        __syncthreads();
        if (F.tid == 0) { int s = 0; for (int e = 0; e < 32; ++e) { pstart[e] = s; s += (cnt[e] + 255) & ~255; } pstart[32] = s; }
        __syncthreads();
        int e_a = 0, tok = 0, k = 0; float w_a = 0.f;
        if (F.tid < 256) { tok = blk * 128 + (F.tid >> 1); k = F.tid & 1; const v4u rc = recs[tok]; e_a = (int)(k ? rc.y : rc.x); w_a = __uint_as_float(k ? rc.w : rc.z); exps[F.tid] = e_a; }
        __syncthreads();
        if (F.tid < 256) { int rank = 0; for (int a = 0; a < F.tid; ++a) rank += (exps[a] == e_a) ? 1 : 0;
            const int dest = pstart[e_a] + base[e_a] + rank; row_tok[dest] = tok; row_w[dest] = w_a; rowof[tok * 2 + k] = dest; }
        if (blk < 32) { const int e = blk; for (int r = pstart[e] + cnt[e] + F.tid; r < pstart[e + 1]; r += NWAVES * 64) { row_tok[r] = 0; row_w[r] = 0.f; } }
        if (blk == 0) { const int np = pstart[32] >> 8; if (F.tid == 0) pinfo[0] = np;
            for (int p = F.tid; p < np; p += NWAVES * 64) { int e = 0; for (int j = 1; j < 32; ++j) if (pstart[j] <= p * 256) e = j; pinfo[16 + p] = e; } }
        __syncthreads();
    }
}
__device__ __forceinline__ void load_pexp(Frame& F) {
    const int* pinfo = (const int*)(F.ws + SM_PINFO); LAS int* px = (LAS int*)(F.lds + PEXP_OFF);
    for (int i = F.tid; i < 16 + 288; i += NWAVES * 64) px[i] = __hip_atomic_load(pinfo + i, RLX_AGENT);
    __syncthreads();
}

__device__ __forceinline__ void p11_final(Frame& F, const Params& P) {
    const bf16* H = (const bf16*)(F.ws + WS_H); const bf16* Y = (const bf16*)(F.ws + WS_Y); const int* rowof = (const int*)(F.ws + SM_ROWOF);
    const float* g2 = P.in[19]; const float* b2 = P.in[20]; float* out = P.out;
    const int gw = F.vcu * NWAVES + F.wave, NGW = F.G * NWAVES, l = F.lane;
    f32x4 gg[4], bb[4];
#pragma unroll
    for (int j = 0; j < 2; ++j) { gg[2 * j] = *(const GAS f32x4*)(g2 + 512 * j + 8 * l); gg[2 * j + 1] = *(const GAS f32x4*)(g2 + 512 * j + 8 * l + 4);
        bb[2 * j] = *(const GAS f32x4*)(b2 + 512 * j + 8 * l); bb[2 * j + 1] = *(const GAS f32x4*)(b2 + 512 * j + 8 * l + 4); }
    for (int rb = gw * 16; rb < M; rb += NGW * 16) {
        const int myidx = (l < 32) ? rowof[rb * 2 + l] : 0;
#pragma unroll 1
        for (int i = 0; i < 16; i += 2) {
            float z[2][16];
#pragma unroll
            for (int u = 0; u < 2; ++u) { const int row = rb + i + u; const int r1 = __shfl(myidx, 2 * (i + u)), r2 = __shfl(myidx, 2 * (i + u) + 1);
#pragma unroll
                for (int j = 0; j < 2; ++j) { const v4u hw = *(const GAS v4u*)(H + (size_t)row * D + 512 * j + 8 * l), y1 = *(const GAS v4u*)(Y + (size_t)r1 * D + 512 * j + 8 * l), y2 = *(const GAS v4u*)(Y + (size_t)r2 * D + 512 * j + 8 * l);
                    float hf[8], a[8], b[8]; unpack8f(hw, hf); unpack8f(y1, a); unpack8f(y2, b);
#pragma unroll
                    for (int e = 0; e < 8; ++e) z[u][8 * j + e] = ALPHA * hf[e] + (a[e] + b[e]); } }
#pragma unroll
            for (int u = 0; u < 2; ++u) { const int row = rb + i + u; float s = 0.f;
#pragma unroll
                for (int e = 0; e < 16; ++e) s += z[u][e];
                const float mean = wave_sum(s) * (1.0f / 1024.0f); float s2 = 0.f;
#pragma unroll
                for (int e = 0; e < 16; ++e) { z[u][e] -= mean; s2 += z[u][e] * z[u][e]; }
                const float rstd = 1.0f / sqrtf(wave_sum(s2) * (1.0f / 1024.0f) + EPS);
#pragma unroll
                for (int j = 0; j < 2; ++j) { f32x4 o0, o1;
#pragma unroll
                    for (int e = 0; e < 4; ++e) { o0[e] = z[u][8 * j + e] * rstd * gg[2 * j][e] + bb[2 * j][e]; o1[e] = z[u][8 * j + 4 + e] * rstd * gg[2 * j + 1][e] + bb[2 * j + 1][e]; }
                    *(GAS f32x4*)(out + (size_t)row * D + 512 * j + 8 * l) = o0; *(GAS f32x4*)(out + (size_t)row * D + 512 * j + 8 * l + 4) = o1; } }
        }
    }
}

__device__ __forceinline__ void attn_phase(Frame& F) {
    const bf16* Q = (const bf16*)(F.outb + OUT_Q); const bf16* K = (const bf16*)(F.ws + WS_K); const bf16* V = (const bf16*)(F.ws + WS_V); bf16* O = (bf16*)(F.ws + WS_O);
    for (int v = F.vcu; v < 256; v += F.G) {
        const int s = v & 7, bh = v >> 3;
#pragma unroll 1
        for (int i = 0; i < 4; ++i) { const int qb = (i == 0) ? s : (i == 1) ? 15 - s : (i == 2) ? 16 + s : 31 - s;
            attn::attn_unit<8>(bh >> 3, bh & 7, qb, Q, K, V, O, F.lds + RING_OFF); }
    }
    __syncthreads();
}

constexpr int N_PHASES = 12;
__global__ void __launch_bounds__(NWAVES * 64, 2) mk_fwd(Params P) {
    extern __shared__ __attribute__((aligned(16))) unsigned char lds_raw[];
    Frame F;
    F.lds = (LAS unsigned char*)lds_raw;
    F.MISC = (volatile LAS unsigned*)(F.lds + MISC_OFF);
    frame_ids(F);
    F.G = gridDim.x; { const int bx = blockIdx.x; F.vcu = (F.G % 8 == 0) ? (bx % 8) * (F.G / 8) + bx / 8 : bx; }
    F.ws = P.ws; F.outb = (unsigned char*)P.out;
    unsigned char* ws = P.ws;
    for (int u = F.tid; u < (LDS_BYTES - LDSCTL_OFF) / 4; u += NWAVES * 64) ((LAS unsigned*)(F.lds + LDSCTL_OFF))[u] = 0u;
    __syncthreads();
    XcdBarrier bar; bar.bar = (unsigned*)(ws + WS_CTL) + CW_BAR; bar.x = 0; bar.st = nullptr;
    if (MK_N_LAUNCHES == 1) bar = xcd_barrier_post((unsigned*)(ws + WS_CTL) + CW_BAR, F.MISC + 8);
    const int lo = P.ph_lo, hi = P.ph_hi;
#define IN(k) (lo <= (k) && (k) < hi)
#define SEAM(k) do { if (IN(k) && IN((k) + 1)) xcd_barrier(bar); } while (0)
    typedef pg8::StaticOrder SO;
#define PH_BEGIN(k) if (IN(k)) { _Pragma("unroll") for (int rep_ = 0; rep_ < (((PROBE_REPEAT_MASK) >> (k)) & 1) + 1; ++rep_) { if (rep_) xcd_barrier(bar);
#define PH_END(k) } } SEAM(k);

    PH_BEGIN(0) frame_ids(F); p0_prologue(F, P); PH_END(0)

    PH_BEGIN(1)
        pg8::OpsPlain G{(const char*)(ws + WS_XB), (const char*)(ws + W_IN_T), 1024, 1024, 0}; SO S; S.init(M / 256, PBW / 256, F.G, (int)blockIdx.x);
        pg8::EpiProj E{(bf16*)(ws + WS_PB)};
        pg8::gemm_phase<pg8::EpiProj, SO, pg8::OpsPlain, true>(F.lds + RING_OFF, G, S, E);
    PH_END(1)

    PH_BEGIN(2) frame_ids(F); p2_thin(F); PH_END(2)

    PH_BEGIN(3)
        {
          pg8::OpsPlain G{(const char*)(ws + WS_POOLED), (const char*)(ws + W_POOL_T), 128, 512, 256}; SO S; S.init(M / 256, 4, F.G, (int)blockIdx.x);
          pg8::EpiPool E{(bf16*)(F.outb + OUT_TP), (const bf16*)(ws + WS_PB), P.in[3]};
          pg8::gemm_phase<pg8::EpiPool, SO, pg8::OpsPlain, true>(F.lds + RING_OFF, G, S, E); }
        __syncthreads();
        {
          pg8::OpsPlain G{(const char*)(ws + WS_PB) + C_CQ * 2, (const char*)(ws + W_UQ_T), 384, PBW, 0}; SO S; S.init(M / 256, 3, F.G, (int)blockIdx.x);
          pg8::EpiQ E{(bf16*)(F.outb + OUT_Q), (const float*)(ws + SM_RQ), (const float*)(ws + SM_ROPE)};
          pg8::gemm_phase<pg8::EpiQ, SO, pg8::OpsPlain, true>(F.lds + RING_OFF, G, S, E); }
        __syncthreads();
        {
          pg8::OpsPlain G{(const char*)(ws + WS_PB) + C_CKV * 2, (const char*)(ws + W_UKV_T), 256, PBW, 0}; SO S; S.init(M / 256, 4, F.G, (int)blockIdx.x);
          pg8::EpiKV E{(bf16*)(ws + WS_K), (bf16*)(ws + WS_V), (const float*)(ws + SM_RKV)};
          pg8::gemm_phase<pg8::EpiKV, SO, pg8::OpsPlain, true>(F.lds + RING_OFF, G, S, E); }
    PH_END(3)

    PH_BEGIN(4) frame_ids(F); attn_phase(F); PH_END(4)

    PH_BEGIN(5)
        pg8::OpsPlain G{(const char*)(ws + WS_O), (const char*)(ws + W_MLAO_T), 512, 512, 0}; SO S; S.init(M / 256, 4, F.G, (int)blockIdx.x);
        pg8::EpiMla E{(bf16*)(F.outb + OUT_TP), (const bf16*)(ws + WS_PB)};
        pg8::gemm_phase<pg8::EpiMla, SO, pg8::OpsPlain, true>(F.lds + RING_OFF, G, S, E);
    PH_END(5)

    PH_BEGIN(6)
        pg8::OpsPlain G{(const char*)(F.outb + OUT_TP), (const char*)(ws + W_OUT_T), 1024, 1024, 0}; SO S; S.init(M / 256, 4, F.G, (int)blockIdx.x);
        pg8::EpiOut E{(bf16*)(ws + WS_VH), P.in[0], (float*)(ws + SM_STATS)};
        pg8::gemm_phase<pg8::EpiOut, SO, pg8::OpsPlain, true>(F.lds + RING_OFF, G, S, E);
    PH_END(6)

    PH_BEGIN(7) frame_ids(F); p7_ln_router(F, P); PH_END(7)
    PH_BEGIN(8) frame_ids(F); p8_scatter(F); PH_END(8)

    PH_BEGIN(9)
        frame_ids(F); load_pexp(F); const LAS int* px = (const LAS int*)(F.lds + PEXP_OFF); const int np = px[0];
        pg8::OpsMoe1 G{(const char*)(ws + WS_H), (const char*)(ws + W_GU_T), 1024, 1024, (const int*)(ws + SM_ROWTOK), px}; SO S; S.init(np, 4, F.G, (int)blockIdx.x);
        pg8::EpiHid E{(bf16*)(ws + WS_HID)};
        pg8::gemm_phase<pg8::EpiHid, SO, pg8::OpsMoe1, true>(F.lds + RING_OFF, G, S, E);
    PH_END(9)

    PH_BEGIN(10)
        frame_ids(F); load_pexp(F); const LAS int* px = (const LAS int*)(F.lds + PEXP_OFF); const int np = px[0];
        pg8::OpsMoe2 G{(const char*)(ws + WS_HID), (const char*)(ws + W_DN_T), 512, 512, px}; SO S; S.init(np, 4, F.G, (int)blockIdx.x);
        pg8::EpiDown E{(bf16*)(ws + WS_Y), (const float*)(ws + SM_ROWW)};
        pg8::gemm_phase<pg8::EpiDown, SO, pg8::OpsMoe2, true>(F.lds + RING_OFF, G, S, E);
    PH_END(10)

    PH_BEGIN(11) frame_ids(F); p11_final(F, P); } }
#undef IN
#undef SEAM
}

extern "C" void kernel_launch(void* const* d_in, const int* in_sizes, int n_in, void* d_out, int out_size, void* d_ws, size_t ws_size, hipStream_t stream) {
    static int grid = 0;
    if (grid == 0) {
        if (n_in != 21 || out_size != M * D || ws_size < WS_END) { fprintf(stderr, "kernel_launch: unexpected shapes: n_in %d out %d ws %zu\n", n_in, out_size, ws_size); grid = -1; return; }
        int dev = 0, cus = 0, per_cu = 0;
        if (hipGetDevice(&dev) != hipSuccess || hipDeviceGetAttribute(&cus, hipDeviceAttributeMultiprocessorCount, dev) != hipSuccess) { grid = -1; return; }
        if (hipFuncSetAttribute((const void*)mk_fwd, hipFuncAttributeMaxDynamicSharedMemorySize, LDS_BYTES) != hipSuccess) { fprintf(stderr, "kernel_launch: hipFuncSetAttribute failed\n"); grid = -1; return; }
        if (hipOccupancyMaxActiveBlocksPerMultiprocessor(&per_cu, (const void*)mk_fwd, NWAVES * 64, LDS_BYTES) != hipSuccess || per_cu < 1) { fprintf(stderr, "kernel_launch: occupancy query says %d\n", per_cu); }
        (void)hipGetLastError();
        grid = cus < 256 ? cus : 256;
    }
    if (grid < 0) return;
    (void)hipMemsetAsync((char*)d_ws + WS_CTL, 0, CTL_ZERO_BYTES, stream);
    Params p{};
    for (int i = 0; i < 21; ++i) p.in[i] = (const float*)d_in[i];
    p.out = (float*)d_out; p.ws = (unsigned char*)d_ws;
#if MK_N_LAUNCHES == 1
    p.ph_lo = 0; p.ph_hi = N_PHASES;
    hipLaunchKernelGGL(mk_fwd, dim3(grid), dim3(NWAVES * 64), LDS_BYTES, stream, p);
#else
    for (int k = 0; k < N_PHASES; ++k) { p.ph_lo = k; p.ph_hi = k + 1; hipLaunchKernelGGL(mk_fwd, dim3(grid), dim3(NWAVES * 64), LDS_BYTES, stream, p); }
#endif
}
```
